# Optimizing an MI355X kernel written in HIP

```python
import jax, jax.numpy as jnp
from jax import lax
import numpy as np

D_MODEL = 2048
BATCH = 4
SEQ = 2048
DEPTH = 2
DEC_BATCH = 128
DEC_SEQ = 4
PAST_LEN = 16384
PAGE_SIZE = 128

N_META = 16
D_CONV = D_MODEL
CONV_W = 3
GLA_HEADS = 4
GLA_DK = D_MODEL // 2 // GLA_HEADS
GLA_DV = D_MODEL // GLA_HEADS
GLA_HK = GLA_HEADS * GLA_DK
GLA_HV = GLA_HEADS * GLA_DV
GATE_RANK = 16
GATE_NORM = 16.0
CHUNK = 64
D_FF = 4 * D_MODEL
ALPHA = (2 * DEPTH) ** 0.25
BETA = (8 * DEPTH) ** -0.25
EPS = 1e-5
SPLITS = (D_CONV, D_CONV, D_CONV, GLA_HK, GLA_HK, GLA_HV, GLA_HV, GATE_RANK, D_MODEL, D_MODEL)
D_IN_PROJ = D_CONV * 3 + GLA_HK * 2 + GLA_HV * 2 + GATE_RANK + D_MODEL * 2

kernel_name = 'gated_conv_gla_hybrid_step'


def layer_norm(x, w, b):
    xf = x.astype(jnp.float32)
    mu = jnp.mean(xf, axis=-1, keepdims=True)
    var = jnp.mean(jnp.square(xf - mu), axis=-1, keepdims=True)
    y = (xf - mu) * lax.rsqrt(var + EPS)
    return (y * w.astype(jnp.float32) + b.astype(jnp.float32)).astype(x.dtype)


def short_conv(u, state, w):
    L = u.shape[1]
    full = jnp.concatenate([state.astype(u.dtype), u], axis=1)
    y = full[:, 0:L] * w[0]
    for j in range(1, CONV_W):
        y = y + full[:, j:j + L] * w[j]
    return y, full[:, L:]


def gla_chunk(s, inp):
    q, k, v, gk = inp
    c = q.shape[2]
    b = jnp.cumsum(gk, axis=2)
    causal = jnp.tril(jnp.ones((c, c), dtype=bool))
    diff = b[:, :, :, None, :] - b[:, :, None, :, :]
    decay = jnp.exp(jnp.where(causal[None, None, :, :, None], diff, -jnp.inf))
    a = jnp.einsum('nhtd,nhsd,nhtsd->nhts', q, k, decay)
    o = jnp.einsum('nhts,nhsv->nhtv', a, v) + jnp.einsum('nhtd,nhdv->nhtv', q * jnp.exp(b), s)
    b_last = b[:, :, -1:, :]
    s_new = jnp.exp(b_last[:, :, 0, :])[..., None] * s + jnp.einsum('nhsd,nhsv->nhdv', k * jnp.exp(b_last - b), v)
    return s_new, o


def gla_sequence(q, k, v, gk, s0, n_lead):
    s = s0.astype(jnp.float32)
    outs = []
    L = q.shape[2]
    lead = n_lead + (L - n_lead) % CHUNK
    bounds = [0, n_lead, lead] if n_lead else [0, lead]
    for lo, hi in zip(bounds[:-1], bounds[1:]):
        if hi > lo:
            s, o = gla_chunk(s, (q[:, :, lo:hi], k[:, :, lo:hi], v[:, :, lo:hi], gk[:, :, lo:hi]))
            outs.append(o)
    n_chunks = (L - lead) // CHUNK
    if n_chunks:
        N, H = q.shape[0], q.shape[1]
        def to_chunks(a):
            return jnp.moveaxis(a[:, :, lead:].reshape(N, H, n_chunks, CHUNK, a.shape[-1]), 2, 0)
        s, o = lax.scan(gla_chunk, s, (to_chunks(q), to_chunks(k), to_chunks(v), to_chunks(gk)))
        outs.append(jnp.moveaxis(o, 0, 2).reshape(N, H, n_chunks * CHUNK, o.shape[-1]))
    return jnp.concatenate(outs, axis=2), s


def token_mixer(u, conv_state, gla_state, n_lead, w_in, conv_w, w_a2, b_a2, gn_w, w_o):
    N, L, _ = u.shape
    idx, acc = [], 0
    for sz in SPLITS[:-1]:
        acc += sz
        idx.append(acc)
    proj = u @ w_in
    cb, cc, cx, q, k, v, g, a1, ga, gb = jnp.split(proj, idx, axis=-1)
    conv_out, conv_new = short_conv(cc * cx, conv_state, conv_w)
    y_a = cb * conv_out
    gk = jax.nn.log_sigmoid((a1 @ w_a2 + b_a2).astype(jnp.float32)) / GATE_NORM
    def heads(a, d):
        return a.reshape(N, L, GLA_HEADS, d).transpose(0, 2, 1, 3).astype(jnp.float32)
    o, gla_new = gla_sequence(heads(q, GLA_DK) * (GLA_DK ** -0.5), heads(k, GLA_DK),
                              heads(v, GLA_DV), heads(gk, GLA_DK), gla_state, n_lead)
    o = o * lax.rsqrt(jnp.mean(jnp.square(o), axis=-1, keepdims=True) + EPS) * gn_w.astype(jnp.float32)
    o = o.transpose(0, 2, 1, 3).reshape(N, L, GLA_HV).astype(u.dtype)
    y_b = o * jax.nn.silu(g)
    m = jax.nn.sigmoid(ga) * y_a + jax.nn.sigmoid(gb) * y_b
    return m @ w_o, conv_new, gla_new


def trunk(h, conv_states, gla_states, n_lead, ln_in_w, ln_in_b, w_in, conv_w, w_a2, b_a2, gn_w,
          w_o, ln1_w, ln1_b, w1, w2, ln2_w, ln2_b):
    h = layer_norm(h, ln_in_w, ln_in_b)
    conv_new, gla_new = [], []
    for l in range(DEPTH):
        mix, cs, gs = token_mixer(h, conv_states[l], gla_states[l], n_lead, w_in[l], conv_w[l],
                                  w_a2[l], b_a2[l], gn_w[l], w_o[l])
        h = layer_norm(ALPHA * h + mix, ln1_w[l], ln1_b[l])
        f = jnp.square(jax.nn.relu(h @ w1[l])) @ w2[l]
        h = layer_norm(ALPHA * h + f, ln2_w[l], ln2_b[l])
        conv_new.append(cs)
        gla_new.append(gs)
    return h, jnp.stack(conv_new), jnp.stack(gla_new)


def setup_inputs(seed: int = 0) -> dict:
    key = jax.random.key(seed)
    ks = jax.random.split(key, 20)
    f32 = jnp.float32
    n = lambda k, shape, s: jax.random.normal(k, shape, f32) * s
    return {
        'x_prompt': n(ks[0], (BATCH, SEQ, D_MODEL), 1.0),
        'x_sample': n(ks[1], (DEC_BATCH, DEC_SEQ, D_MODEL), 1.0),
        'state_conv': n(ks[2], (DEPTH, DEC_BATCH, CONV_W - 1, D_CONV), 1.0),
        'state_gla': n(ks[3], (DEPTH, DEC_BATCH, GLA_HEADS, GLA_DK, GLA_DV), 1.0),
        'meta': n(ks[4], (N_META, D_MODEL), 1.0),
        'ln_in_w': 1.0 + n(ks[5], (D_MODEL,), 0.02),
        'ln_in_b': n(ks[6], (D_MODEL,), 0.02),
        'w_in': n(ks[7], (DEPTH, D_MODEL, D_IN_PROJ), D_MODEL ** -0.5),
        'conv_w': n(ks[8], (DEPTH, CONV_W, D_CONV), CONV_W ** -0.5),
        'w_a2': n(ks[9], (DEPTH, GATE_RANK, GLA_HK), GATE_RANK ** -0.5),
        'b_a2': n(ks[10], (DEPTH, GLA_HK), 0.1),
        'gn_w': 1.0 + n(ks[11], (DEPTH, GLA_DV), 0.02),
        'w_o': n(ks[12], (DEPTH, D_MODEL, D_MODEL), BETA * D_MODEL ** -0.5),
        'ln1_w': 1.0 + n(ks[13], (DEPTH, D_MODEL), 0.02),
        'ln1_b': n(ks[14], (DEPTH, D_MODEL), 0.02),
        'w1': n(ks[15], (DEPTH, D_MODEL, D_FF), D_MODEL ** -0.5),
        'w2': n(ks[16], (DEPTH, D_FF, D_MODEL), BETA * D_FF ** -0.5),
        'ln2_w': 1.0 + n(ks[17], (DEPTH, D_MODEL), 0.02),
        'ln2_b': n(ks[18], (DEPTH, D_MODEL), 0.02),
    }


def reference(x_prompt, x_sample, state_conv, state_gla, meta, ln_in_w, ln_in_b, w_in, conv_w,
              w_a2, b_a2, gn_w, w_o, ln1_w, ln1_b, w1, w2, ln2_w, ln2_b):
    params = (ln_in_w, ln_in_b, w_in, conv_w, w_a2, b_a2, gn_w, w_o, ln1_w, ln1_b, w1, w2, ln2_w, ln2_b)
    nb = x_prompt.shape[0]
    h = jnp.concatenate([jnp.broadcast_to(meta.astype(x_prompt.dtype), (nb, N_META, D_MODEL)), x_prompt], axis=1)
    conv0 = jnp.zeros((DEPTH, nb, CONV_W - 1, D_CONV), x_prompt.dtype)
    gla0 = jnp.zeros((DEPTH, nb, GLA_HEADS, GLA_DK, GLA_DV), jnp.float32)
    hp, conv_p, gla_p = trunk(h, conv0, gla0, N_META, *params)
    y_prompt = hp[:, N_META:]
    y_sample, conv_s, gla_s = trunk(x_sample, state_conv, state_gla, 0, *params)
    return (y_prompt, y_sample, conv_p, gla_p, conv_s, gla_s)
```

```cpp
#include <hip/hip_runtime.h>
#include <cstdio>
#include <cstdint>

#define GAS __attribute__((address_space(1)))
#define LAS __attribute__((address_space(3)))
typedef unsigned short bf16;
typedef short bf16x8 __attribute__((ext_vector_type(8)));
typedef float f32x4 __attribute__((ext_vector_type(4)));
typedef float f32x2 __attribute__((ext_vector_type(2)));
typedef unsigned u32x4 __attribute__((ext_vector_type(4)));
typedef unsigned u32x2 __attribute__((ext_vector_type(2)));

#ifndef DBG_STAGE
#define DBG_STAGE 99
#endif

constexpr int DM = 2048, NB = 4, SEQ = 2048, NMETA = 16, LP = SEQ + NMETA, NPROMPT = NB * LP;
constexpr int DECB = 128, DECS = 4, NSAMP = DECB * DECS, NTOK = NPROMPT + NSAMP, MP = 8960;
constexpr int DEPTH = 2, NH = 4, DK = 256, DV = 512, HK = 1024, HV = 2048, RANK = 16, DFF = 8192;
constexpr int DIN = 16400, NPROJ = 16640;
constexpr int C_CB = 0, C_CC = 2048, C_CX = 4096, C_Q = 6144, C_K = 7168, C_V = 8192, C_G = 10240, C_GA = 12288, C_GB = 14336, C_A1 = 16384;
constexpr int NCHUNK = 33, NPCH = NB * NCHUNK;
constexpr float LN_EPS = 1e-5f;
constexpr float ALPHA = 1.41421356237f;
constexpr size_t O_YP = 0, O_YS = 16777216, O_CP = 17825792, O_GP = 17858560, O_CS = 22052864, O_GS = 23101440, O_END = 157319168;

constexpr size_t MiB = 1u << 20;
constexpr size_t WS_CTL = 0, CTL_ZERO_BYTES = 1 * MiB;
constexpr size_t WS_WIN = 1 * MiB, WS_WO = 131 * MiB, WS_W1 = 147 * MiB, WS_W2 = 211 * MiB;
constexpr size_t WS_HF = 275 * MiB, WS_HB = 345 * MiB, WS_TF = 380 * MiB, WS_PROJ = 450 * MiB, WS_MB = 735 * MiB, WS_RB = 770 * MiB, WS_OB = 910 * MiB;
constexpr size_t WS_QF = 980 * MiB, WS_KTF = 997 * MiB, WS_AF = 1014 * MiB, WS_VTF = 1019 * MiB, WS_EB = 1052 * MiB, WS_END = 1053 * MiB;
constexpr int CW_BAR = 4096;

constexpr int RING_BYTES = 131072, LDSCTL_OFF = RING_BYTES, MISC_OFF = LDSCTL_OFF + 320, LDS_BYTES = 147456;

#define LDS_WAIT() asm volatile("s_waitcnt lgkmcnt(0)" ::: "memory")
#define VM_WAIT() asm volatile("s_waitcnt vmcnt(0)" ::: "memory")
__device__ __forceinline__ unsigned cvt_pk_bf16(float lo, float hi) { unsigned r; asm volatile("v_cvt_pk_bf16_f32 %0, %1, %2" : "=v"(r) : "v"(lo), "v"(hi)); return r; }
__device__ __forceinline__ float bf2f(unsigned u16v) { return __uint_as_float(u16v << 16); }
__device__ __forceinline__ float bflo(unsigned w) { return __uint_as_float(w << 16); }
__device__ __forceinline__ float bfhi(unsigned w) { return __uint_as_float(w & 0xffff0000u); }
__device__ __forceinline__ bf16 f2bf(float f) { unsigned u = __float_as_uint(f); return (bf16)((u + 0x7fffu + ((u >> 16) & 1u)) >> 16); }
__device__ __forceinline__ float wave_sum(float v) {
#pragma unroll
    for (int o = 1; o < 64; o <<= 1) v += __shfl_xor(v, o);
    return v;
}
__device__ __forceinline__ float sigmoidf_(float x) { return 1.0f / (1.0f + __expf(-x)); }
__device__ __forceinline__ float logsigmoidf_(float z) { return fminf(z, 0.f) - __logf(1.0f + __expf(-fabsf(z))); }

namespace pg8 {
#define PG8_LAS __attribute__((address_space(3)))
typedef unsigned short bf16_t;
constexpr int BM = 256, BK = 64, HALF = 128, HTB = HALF * BK * 2, STAGE_BYTES = 8 * HTB, NXCD = 8, WGM = 8;
__host__ __device__ __forceinline__ int lds_byte(int r, int c) { const int st = (r >> 4) * 2 + (c >> 5), rr = r & 15, cc = c & 31, ob = rr * 64 + cc * 2; return st * 1024 + (ob ^ (((ob >> 9) & 1) << 5)); }
__host__ __device__ __forceinline__ void stage_rc(int b, int& R, int& C) { const int st = b / 1024, sb = b % 1024, swz = sb ^ (((sb >> 9) & 1) << 5); R = (st >> 1) * 16 + swz / 64; C = (st & 1) * 32 + (swz % 64) / 2; }
__host__ __device__ __forceinline__ int perm32(int rho) { const int n = rho >> 4, i = rho & 15; return 8 * (i >> 2) + 4 * n + (i & 3); }
struct Unit { int pm, pn; };
struct Gemm { const bf16_t* A; const bf16_t* Bt; int M, N, K; };
struct StaticOrder {
    int nM, nN, nwg, G, c;
    __host__ __device__ void init(int M, int N, int G_, int c_) { nM = M / BM; nN = N / BM; nwg = nM * nN; G = G_; c = c_; }
    __host__ __device__ bool next(int i, Unit& u) const {
        const long L = (long)i * G + c; if (L >= nwg) return false;
        int wgid = (int)L; { const int q = nwg / NXCD, r = nwg % NXCD, xcd = wgid % NXCD, off = wgid / NXCD; wgid = (xcd < r ? xcd * (q + 1) : r * (q + 1) + (xcd - r) * q) + off; }
        const int nig = WGM * nN, gid = wgid / nig, fm = gid * WGM, gsz = (nM - fm) < WGM ? (nM - fm) : WGM;
        u.pm = fm + ((wgid % nig) % gsz); u.pn = (wgid % nig) / gsz; return true;
    }
    __device__ __forceinline__ void a_ready(const Unit&) const {}
    __device__ __forceinline__ void done(const Unit&) const {}
};
template <int ACT  > struct EpiBf16 {
    static constexpr bool PERM = true, AFTER_DRAIN = false;
    bf16_t* O; int ldc;
    __device__ __forceinline__ void operator()(const f32x4 (&acc)[2][2][4][2], const Unit& u, int wr, int wc, int fr, int fq) const {
        const int row0 = u.pm * BM + wr * 64 + fr; const int col0 = u.pn * BM + wc * 32 + 8 * fq;
#pragma unroll
        for (int ai = 0; ai < 2; ++ai)
#pragma unroll
            for (int m = 0; m < 4; ++m) { bf16_t* rowp = O + (size_t)(row0 + ai * HALF + m * 16) * ldc + col0;
#pragma unroll
                for (int bj = 0; bj < 2; ++bj) { f32x4 v0 = acc[ai][bj][m][0], v1 = acc[ai][bj][m][1];
                    if (ACT == 1) {
#pragma unroll
                        for (int j = 0; j < 4; ++j) { const float a = fmaxf(v0[j], 0.f), b = fmaxf(v1[j], 0.f); v0[j] = a * a; v1[j] = b * b; } }
                    u32x4 w; w.x = cvt_pk_bf16(v0[0], v0[1]); w.y = cvt_pk_bf16(v0[2], v0[3]); w.z = cvt_pk_bf16(v1[0], v1[1]); w.w = cvt_pk_bf16(v1[2], v1[3]);
                    *(u32x4*)(rowp + bj * HALF) = w; } }
    }
};
struct EpiResF32 {
    static constexpr bool PERM = false, AFTER_DRAIN = false;
    float* C; const float* res; int ldc; float alpha;
    __device__ __forceinline__ void operator()(const f32x4 (&acc)[2][2][4][2], const Unit& u, int wr, int wc, int fr, int fq) const {
        const int row0 = u.pm * BM + wr * 64 + fr, col0 = u.pn * BM + wc * 32 + 4 * fq;
#pragma unroll
        for (int ai = 0; ai < 2; ++ai)
#pragma unroll
            for (int m = 0; m < 4; ++m) { const size_t off = (size_t)(row0 + ai * HALF + m * 16) * ldc + col0;
#pragma unroll
                for (int bj = 0; bj < 2; ++bj)
#pragma unroll
                    for (int n = 0; n < 2; ++n) { const f32x4 r = *(const f32x4*)(res + off + bj * HALF + n * 16); *(f32x4*)(C + off + bj * HALF + n * 16) = r * alpha + acc[ai][bj][m][n]; } }
    }
};

template <class Epi, class Sched, bool ALIGN_EPI = false, bool SP2 = false>
__device__ __forceinline__ void gemm_phase(PG8_LAS unsigned char* lds, const Gemm g, const Sched& S, const Epi& E) {
    int tid_ = threadIdx.x; asm volatile("" : "+v"(tid_));
    const int tid = tid_, wid = __builtin_amdgcn_readfirstlane(tid >> 6), lane = tid & 63, wr = wid >> 2, wc = wid & 3, fr = lane & 15, fq = lane >> 4;
    const int K = g.K, nt = K / BK;
    unsigned voffA[2], voffB[2];
#pragma unroll
    for (int i = 0; i < 2; ++i) { int R, C; stage_rc(tid * 16 + i * 8192, R, C); const int Rb = Epi::PERM ? ((R & ~31) + perm32(R & 31)) : R;
        voffA[i] = (unsigned)(R * K + C) * 2u; voffB[i] = (unsigned)(Rb * K + C) * 2u; }
    const size_t kstep = (size_t)(BK * 2);
    const size_t hstep = (size_t)HALF * K * 2;
    const size_t tstep = 2 * hstep;
    const unsigned ldsw = (unsigned)wid * 1024u;
    const int aoff = lds_byte(wr * 64 + fr, fq * 8), boff = lds_byte(wc * 32 + fr, fq * 8);
#define PG8_SA(b, h) (((b) * 2 + (h)) * HTB)
#define PG8_SB(b, h) ((4 + (b) * 2 + (h)) * HTB)
#define PG8_STAGE(bufoff, gbase, voff) do { _Pragma("unroll") for (int _i = 0; _i < 2; ++_i) \
        __builtin_amdgcn_global_load_lds((const unsigned*)((const char*)(gbase) + (voff)[_i]), (PG8_LAS unsigned*)(lds + (bufoff) + ldsw + _i * 8192), 16, 0, 0); } while (0)
#define PG8_LDA(dst, b, h) do { _Pragma("unroll") for (int m = 0; m < 4; ++m) _Pragma("unroll") for (int k = 0; k < 2; ++k) dst[m][k] = *(const PG8_LAS bf16x8*)(lds + PG8_SA(b, h) + aoff + m * 2048 + k * 1024); } while (0)
#define PG8_LDB(dst, b, h) do { _Pragma("unroll") for (int n = 0; n < 2; ++n) _Pragma("unroll") for (int k = 0; k < 2; ++k) dst[n][k] = *(const PG8_LAS bf16x8*)(lds + PG8_SB(b, h) + boff + n * 2048 + k * 1024); } while (0)
#define PG8_MMA(ai, bj, At, Bt) do { __builtin_amdgcn_s_setprio(1); _Pragma("unroll") for (int m = 0; m < 4; ++m) _Pragma("unroll") for (int n = 0; n < 2; ++n) _Pragma("unroll") for (int k = 0; k < 2; ++k) \
        acc[ai][bj][m][n] = __builtin_amdgcn_mfma_f32_16x16x32_bf16(Bt[n][k], At[m][k], acc[ai][bj][m][n], 0, 0, 0); __builtin_amdgcn_s_setprio(0); } while (0)
#define PG8_WAIT_V(n) asm volatile("s_waitcnt vmcnt(" #n ")" ::: "memory")
#define PG8_WAIT_L(n) asm volatile("s_waitcnt lgkmcnt(" #n ")" ::: "memory")
#define PG8_BAR __builtin_amdgcn_s_barrier()
#define PG8_SCHED __builtin_amdgcn_sched_barrier(0)
    Unit cur, nxt; int ui = 0;
    if (!S.next(0, cur)) return;
    f32x4 acc[2][2][4][2];
#pragma unroll
    for (int a = 0; a < 2; ++a)
#pragma unroll
        for (int b = 0; b < 2; ++b)
#pragma unroll
            for (int m = 0; m < 4; ++m)
#pragma unroll
                for (int n = 0; n < 2; ++n) acc[a][b][m][n] = (f32x4){0.f, 0.f, 0.f, 0.f};
    bf16x8 At[4][2], B0[2][2], B1[2][2];
    const char* cA = (const char*)g.A + (size_t)cur.pm * tstep; const char* cB = (const char*)g.Bt + (size_t)cur.pn * tstep;
    S.a_ready(cur);
    if constexpr (SP2) {
        PG8_STAGE(PG8_SB(0, 0), cB, voffB); PG8_STAGE(PG8_SB(0, 1), cB + hstep, voffB); PG8_STAGE(PG8_SA(0, 0), cA, voffA); PG8_STAGE(PG8_SA(0, 1), cA + hstep, voffA);
        if (wr == 1) PG8_BAR;
        PG8_WAIT_V(2); PG8_BAR;
        PG8_STAGE(PG8_SB(1, 0), cB + kstep, voffB); PG8_STAGE(PG8_SA(1, 0), cA + kstep, voffA); PG8_STAGE(PG8_SB(1, 1), cB + hstep + kstep, voffB);
        PG8_WAIT_V(6); PG8_BAR;
    } else {
        PG8_STAGE(PG8_SB(0, 0), cB, voffB); PG8_STAGE(PG8_SA(0, 0), cA, voffA); PG8_STAGE(PG8_SB(0, 1), cB + hstep, voffB); PG8_STAGE(PG8_SA(0, 1), cA + hstep, voffA);
        if (wr == 1) PG8_BAR;
        PG8_WAIT_V(4); PG8_BAR;
        PG8_STAGE(PG8_SB(1, 0), cB + kstep, voffB); PG8_STAGE(PG8_SA(1, 0), cA + kstep, voffA); PG8_STAGE(PG8_SB(1, 1), cB + hstep + kstep, voffB);
        PG8_WAIT_V(6); PG8_BAR;
    }
    for (;;) {
        const bool has_next = S.next(ui + 1, nxt);
        const char* nA = has_next ? (const char*)g.A + (size_t)nxt.pm * tstep : cA; const char* nB = has_next ? (const char*)g.Bt + (size_t)nxt.pn * tstep : cB;
        for (int t = 0; t < nt; t += 2) {
            const bool last = (t == nt - 2);
            const char* a1 = cA + (size_t)(t + 1) * kstep;
            const char* a2 = last ? nA : cA + (size_t)(t + 2) * kstep; const char* b2 = last ? nB : cB + (size_t)(t + 2) * kstep;
            const char* a3 = a2 + kstep; const char* b3 = b2 + kstep;
            if (last && has_next) S.a_ready(nxt);
            if constexpr (SP2) {
            PG8_LDB(B0, 0, 0); PG8_LDB(B1, 0, 1); PG8_SCHED; PG8_LDA(At, 0, 0); PG8_STAGE(PG8_SA(1, 1), a1 + hstep, voffA);
            PG8_WAIT_V(8); PG8_WAIT_L(0); PG8_BAR; PG8_MMA(0, 0, At, B0); PG8_MMA(0, 1, At, B1); PG8_BAR; PG8_SCHED;
            PG8_LDA(At, 0, 1); PG8_STAGE(PG8_SB(0, 0), b2, voffB); PG8_STAGE(PG8_SB(0, 1), b2 + hstep, voffB); PG8_STAGE(PG8_SA(0, 0), a2, voffA);
            PG8_WAIT_V(8); PG8_WAIT_L(0); PG8_BAR; PG8_MMA(1, 0, At, B0); PG8_MMA(1, 1, At, B1); PG8_BAR; PG8_SCHED;
            PG8_LDB(B0, 1, 0); PG8_LDB(B1, 1, 1); PG8_SCHED; PG8_LDA(At, 1, 0); PG8_STAGE(PG8_SA(0, 1), a2 + hstep, voffA);
            PG8_WAIT_V(8); PG8_WAIT_L(0); PG8_BAR; PG8_MMA(0, 0, At, B0); PG8_MMA(0, 1, At, B1); PG8_BAR; PG8_SCHED;
            PG8_LDA(At, 1, 1); PG8_STAGE(PG8_SB(1, 0), b3, voffB); PG8_STAGE(PG8_SB(1, 1), b3 + hstep, voffB); PG8_STAGE(PG8_SA(1, 0), a3, voffA);
            PG8_WAIT_V(8); PG8_WAIT_L(0); PG8_BAR; PG8_MMA(1, 0, At, B0); PG8_MMA(1, 1, At, B1); PG8_BAR; PG8_SCHED;
            } else {
            PG8_LDB(B0, 0, 0); PG8_SCHED; PG8_LDA(At, 0, 0); PG8_STAGE(PG8_SA(1, 1), a1 + hstep, voffA);
            PG8_WAIT_L(8); PG8_BAR; PG8_WAIT_L(0); PG8_MMA(0, 0, At, B0); PG8_BAR; PG8_SCHED;
            PG8_LDB(B1, 0, 1); PG8_STAGE(PG8_SB(0, 0), b2, voffB);
            PG8_BAR; PG8_WAIT_L(0); PG8_MMA(0, 1, At, B1); PG8_BAR;
            PG8_LDA(At, 0, 1); PG8_STAGE(PG8_SA(0, 0), a2, voffA);
            PG8_BAR; PG8_WAIT_L(0); PG8_MMA(1, 0, At, B0); PG8_BAR; PG8_SCHED;
            PG8_STAGE(PG8_SB(0, 1), b2 + hstep, voffB);
            PG8_WAIT_V(6); PG8_BAR; PG8_MMA(1, 1, At, B1); PG8_BAR;
            PG8_LDB(B0, 1, 0); PG8_SCHED; PG8_LDA(At, 1, 0); PG8_STAGE(PG8_SA(0, 1), a2 + hstep, voffA);
            PG8_WAIT_L(8); PG8_BAR; PG8_WAIT_L(0); PG8_MMA(0, 0, At, B0); PG8_BAR; PG8_SCHED;
            PG8_LDB(B1, 1, 1); PG8_STAGE(PG8_SB(1, 0), b3, voffB);
            PG8_BAR; PG8_WAIT_L(0); PG8_MMA(0, 1, At, B1); PG8_BAR;
            PG8_LDA(At, 1, 1); PG8_STAGE(PG8_SA(1, 0), a3, voffA);
            PG8_BAR; PG8_WAIT_L(0); PG8_MMA(1, 0, At, B0); PG8_BAR; PG8_SCHED;
            PG8_STAGE(PG8_SB(1, 1), b3 + hstep, voffB);
            PG8_WAIT_V(6); PG8_BAR; PG8_MMA(1, 1, At, B1); PG8_BAR;
            }
        }
        if constexpr (ALIGN_EPI) { if (wr == 0) PG8_BAR; }
        if constexpr (!Epi::AFTER_DRAIN) { E(acc, cur, wr, wc, fr, fq); S.done(cur); }
        if (!has_next) break;
#pragma unroll
        for (int a = 0; a < 2; ++a)
#pragma unroll
            for (int b = 0; b < 2; ++b)
#pragma unroll
                for (int m = 0; m < 4; ++m)
#pragma unroll
                    for (int n = 0; n < 2; ++n) acc[a][b][m][n] = (f32x4){0.f, 0.f, 0.f, 0.f};
        cur = nxt; cA = nA; cB = nB; ++ui;
        if constexpr (ALIGN_EPI) { if (wr == 1) PG8_BAR; }
    }
    PG8_WAIT_V(0);
    if constexpr (!ALIGN_EPI) { if (wr == 0) PG8_BAR; }
    PG8_BAR;
#undef PG8_SA
#undef PG8_SB
#undef PG8_STAGE
#undef PG8_LDA
#undef PG8_LDB
#undef PG8_MMA
#undef PG8_WAIT_V
#undef PG8_WAIT_L
#undef PG8_BAR
#undef PG8_SCHED
}
}

#define XB_TMO      128
#define XB_XCNT(j)  (256  + 64 * (j))
#define XB_XSUB(j)  (1280 + 64 * (j))
#define XB_XGEN(j)  (2304 + 64 * (j))
#define XB_TOP      3328
#define XB_TOPGEN   3392
#define XCD_BAR_WORDS 3456
#define XB_SPIN_CAP (1u << 18)
__device__ __forceinline__ unsigned xb_ld(unsigned* p)              { return __hip_atomic_load(p, __ATOMIC_RELAXED, __HIP_MEMORY_SCOPE_AGENT); }
__device__ __forceinline__ unsigned xb_add(unsigned* p, unsigned v) { return __hip_atomic_fetch_add(p, v, __ATOMIC_RELAXED, __HIP_MEMORY_SCOPE_AGENT); }
__device__ __forceinline__ unsigned xb_xcc_id() { return (unsigned)__builtin_amdgcn_s_getreg((3 << 11) | 20) & 0xFu; }
#define XB_SPIN(cond, bar) do { unsigned _sp = 0; while (cond) { __builtin_amdgcn_s_sleep(1); \
    if ((++_sp & 255u) == 0u) { if (xb_ld(&(bar)[XB_TMO])) break; if (_sp > XB_SPIN_CAP) { atomicAdd(&(bar)[XB_TMO], 1u); break; } } } } while (0)
struct XcdBarrier { unsigned* bar; unsigned x; volatile LAS unsigned* st; };
__device__ __forceinline__ XcdBarrier xcd_barrier_post(unsigned* bar, volatile LAS unsigned* st) {
    XcdBarrier b; b.bar = bar; b.x = xb_xcc_id(); b.st = st;
    if (threadIdx.x == 0) (void)xb_add(&bar[XB_XCNT(b.x)], 1u);
    return b;
}
__device__ __forceinline__ void xcd_barrier_complete(unsigned* bar, unsigned x, unsigned& nloc, unsigned& nx) {
    const unsigned G = gridDim.x * gridDim.y * gridDim.z;
    unsigned sum, cnt, mine, sp = 0u;
    for (;;) {
        sum = 0u; cnt = 0u; mine = 0u;
#pragma unroll
        for (unsigned j = 0; j < 16; ++j) { const unsigned c = xb_ld(&bar[XB_XCNT(j)]); sum += c; cnt += (c > 0u) ? 1u : 0u; mine = (j == x) ? c : mine; }
        if (sum == G) break;
        __builtin_amdgcn_s_sleep(1);
        if ((++sp & 255u) == 0u) { if (xb_ld(&bar[XB_TMO])) break; if (sp > XB_SPIN_CAP) { atomicAdd(&bar[XB_TMO], 1u); break; } }
    }
    nloc = mine > 0u ? mine : 1u; nx = cnt > 0u ? cnt : 1u;
}
__device__ __forceinline__ void xcd_barrier(const XcdBarrier& b) {
    asm volatile("s_waitcnt vmcnt(0)" ::: "memory");
    __syncthreads();
    if (threadIdx.x == 0) {
        unsigned* bar = b.bar;
        __builtin_amdgcn_s_waitcnt(0);
        unsigned nloc = b.st[0], nx = b.st[1];
        if (nloc == 0u) { xcd_barrier_complete(bar, b.x, nloc, nx); b.st[0] = nloc; b.st[1] = nx; }
        const unsigned old = xb_add(&bar[XB_XSUB(b.x)], 1u);
        const unsigned gen = old / nloc;
        if (old + 1u == (gen + 1u) * nloc) {
            __builtin_amdgcn_fence(__ATOMIC_RELEASE, "agent");
            asm volatile("s_waitcnt vmcnt(0)" ::: "memory");
            const unsigned og = xb_add(&bar[XB_TOP], 1u);
            const unsigned tg = og / nx;
            if (og + 1u == (tg + 1u) * nx) xb_add(&bar[XB_TOPGEN], 1u);
            else XB_SPIN(xb_ld(&bar[XB_TOPGEN]) == tg, bar);
            __builtin_amdgcn_fence(__ATOMIC_ACQUIRE, "agent");
            xb_add(&bar[XB_XGEN(b.x)], 1u);
            asm volatile("s_waitcnt vmcnt(0)" ::: "memory");
        } else {
            XB_SPIN(xb_ld(&bar[XB_XGEN(b.x)]) == gen, bar);
            __builtin_amdgcn_fence(__ATOMIC_ACQUIRE, "agent");
            asm volatile("s_waitcnt vmcnt(0)" ::: "memory");
        }
    }
    __syncthreads();
}

struct Params { const float* in[19]; float* out; unsigned char* ws; int dbg; int pad; };
enum { I_XP = 0, I_XS, I_SCONV, I_SGLA, I_META, I_LNW, I_LNB, I_WIN, I_CONVW, I_WA2, I_BA2, I_GNW, I_WO, I_LN1W, I_LN1B, I_W1, I_W2, I_LN2W, I_LN2B };

struct Frame {
    LAS unsigned char* lds;
    int wave, vcu, G;
};
__device__ __forceinline__ int otid() { int t = threadIdx.x; asm volatile("" : "+v"(t)); return t; }

__device__ __forceinline__ void cvt_tile(const float* W, int ldw, int k0, int nsrc0, bf16* WT, int K, int ndst0, LAS float* scr, int lane) {
    f32x4 v[16];
    const int r = lane >> 4, c4 = lane & 15;
#pragma unroll
    for (int i = 0; i < 16; ++i) v[i] = *(const f32x4*)(W + (size_t)(k0 + 4 * i + r) * ldw + nsrc0 + 4 * c4);
#pragma unroll
    for (int i = 0; i < 16; ++i) { const int k = 4 * i + r; *(LAS f32x4*)(scr + k * 64 + ((4 * c4) ^ (((k >> 3) & 7) << 2))) = v[i]; }
    LDS_WAIT();
    const int c = lane & 7, nn = lane >> 3;
#pragma unroll
    for (int p = 0; p < 8; ++p) { const int n = 8 * p + nn; const LAS float* s = scr + (8 * c) * 64 + (n ^ (c << 2));
        u32x4 o; o.x = cvt_pk_bf16(s[0], s[64]); o.y = cvt_pk_bf16(s[128], s[192]); o.z = cvt_pk_bf16(s[256], s[320]); o.w = cvt_pk_bf16(s[384], s[448]);
        *(u32x4*)(WT + (size_t)(ndst0 + n) * K + k0 + 8 * c) = o; }
    LDS_WAIT();
}
__device__ __forceinline__ void ln_row(const float* xrow, const float* w, const float* b, float* of, bf16* ob, int lane) {
    const f32x4* xr = (const f32x4*)xrow + lane;
    f32x4 v[8]; float s = 0.f;
#pragma unroll
    for (int j = 0; j < 8; ++j) { v[j] = xr[64 * j]; s += (v[j].x + v[j].y) + (v[j].z + v[j].w); }
    const float mean = wave_sum(s) * (1.f / DM); float s2 = 0.f;
#pragma unroll
    for (int j = 0; j < 8; ++j) { v[j] = v[j] - mean; s2 += (v[j].x * v[j].x + v[j].y * v[j].y) + (v[j].z * v[j].z + v[j].w * v[j].w); }
    const float rstd = 1.f / sqrtf(wave_sum(s2) * (1.f / DM) + LN_EPS);
#pragma unroll
    for (int j = 0; j < 8; ++j) { const f32x4 ww = ((const f32x4*)w)[lane + 64 * j], bb = ((const f32x4*)b)[lane + 64 * j]; const f32x4 y = v[j] * rstd * ww + bb;
        if (of) ((f32x4*)of)[lane + 64 * j] = y;
        if (ob) { u32x2 o; o.x = cvt_pk_bf16(y.x, y.y); o.y = cvt_pk_bf16(y.z, y.w); ((u32x2*)ob)[lane + 64 * j] = o; } }
}

__device__ __forceinline__ void p0_prologue(const Frame& F, const Params& P) {
    unsigned char* ws = P.ws;
    const int tid = otid(), lane = tid & 63;
    LAS float* scr = (LAS float*)(F.lds + F.wave * 16384);
    const int gw = F.vcu * 8 + F.wave, NGW = F.G * 8;
    constexpr int I_IN = 32 * 256, I_O = 32 * 32, I_1 = 32 * 128, I_2 = 128 * 32, I_L = I_IN + I_O + I_1 + I_2;
    for (int it = gw; it < DEPTH * I_L; it += NGW) {
        const int l = it / I_L; int r = it % I_L;
        if (r < I_IN) { const int kb = r >> 8, nb = r & 255; const int nd = nb * 64, nsrc = nd + (nd >= C_GA ? 16 : 0);
            cvt_tile(P.in[I_WIN] + (size_t)l * DM * DIN, DIN, kb * 64, nsrc, (bf16*)(ws + WS_WIN) + (size_t)l * NPROJ * DM, DM, nd, scr, lane); continue; }
        r -= I_IN;
        if (r < I_O) { const int kb = r >> 5, nb = r & 31; cvt_tile(P.in[I_WO] + (size_t)l * DM * DM, DM, kb * 64, nb * 64, (bf16*)(ws + WS_WO) + (size_t)l * DM * DM, DM, nb * 64, scr, lane); continue; }
        r -= I_O;
        if (r < I_1) { const int kb = r >> 7, nb = r & 127; cvt_tile(P.in[I_W1] + (size_t)l * DM * DFF, DFF, kb * 64, nb * 64, (bf16*)(ws + WS_W1) + (size_t)l * DFF * DM, DM, nb * 64, scr, lane); continue; }
        r -= I_1;
        { const int kb = r >> 5, nb = r & 31; cvt_tile(P.in[I_W2] + (size_t)l * DFF * DM, DM, kb * 64, nb * 64, (bf16*)(ws + WS_W2) + (size_t)l * DM * DFF, DFF, nb * 64, scr, lane); }
    }
    const int gt = F.vcu * 512 + tid, NGT = F.G * 512;
    for (int i = gt; i < DEPTH * DM * 16; i += NGT) { const int l = i / (DM * 16), r = i % (DM * 16), k = r >> 4, j = r & 15;
        ((bf16*)(ws + WS_WIN))[(size_t)l * NPROJ * DM + (size_t)(C_A1 + j) * DM + k] = f2bf(P.in[I_WIN][(size_t)l * DM * DIN + (size_t)k * DIN + 12288 + j]); }
    constexpr int ZR = NPROJ - (C_A1 + 16);
    for (int i = gt; i < DEPTH * ZR * (DM / 8); i += NGT) { const int l = i / (ZR * (DM / 8)), r = i % (ZR * (DM / 8));
        ((u32x4*)((bf16*)(ws + WS_WIN) + (size_t)l * NPROJ * DM + (size_t)(C_A1 + 16) * DM))[r] = (u32x4){0u, 0u, 0u, 0u}; }
    for (int m = gw; m < MP; m += NGW) {
        float* of = (float*)(ws + WS_HF) + (size_t)m * DM; bf16* ob = (bf16*)(ws + WS_HB) + (size_t)m * DM;
        if (m >= NTOK) { ((u32x4*)ob)[lane] = (u32x4){0u, 0u, 0u, 0u}; ((u32x4*)ob)[lane + 64] = (u32x4){0u, 0u, 0u, 0u}; ((u32x4*)ob)[lane + 128] = (u32x4){0u, 0u, 0u, 0u}; ((u32x4*)ob)[lane + 192] = (u32x4){0u, 0u, 0u, 0u}; continue; }
        const float* src;
        if (m < NPROMPT) { const int b = m / LP, t = m % LP; src = (t < NMETA) ? P.in[I_META] + (size_t)t * DM : P.in[I_XP] + ((size_t)b * SEQ + (t - NMETA)) * DM; }
        else src = P.in[I_XS] + (size_t)(m - NPROMPT) * DM;
        ln_row(src, P.in[I_LNW], P.in[I_LNB], of, ob, lane);
    }
}

__device__ __forceinline__ void gla_prep_unit(const Frame& F, const Params& P, int l, int ci, int h) {
    unsigned char* ws = P.ws;
    const bf16* proj = (const bf16*)(ws + WS_PROJ);
    LAS float* a1s = (LAS float*)(F.lds);
    LAS bf16* Qs = (LAS bf16*)(F.lds + 4096);
    LAS bf16* Ks = (LAS bf16*)(F.lds + 37888);
    LAS bf16* As = (LAS bf16*)(F.lds + 71680);
    const int n = ci / NCHUNK, c = ci % NCHUNK;
    const int tok0 = (c == 0) ? 0 : NMETA + 64 * (c - 1), len = (c == 0) ? NMETA : 64, row0 = n * LP + tok0;
    const int u = ci * NH + h;
    bf16* QFb = (bf16*)(ws + WS_QF) + (size_t)u * 16384; bf16* KTFb = (bf16*)(ws + WS_KTF) + (size_t)u * 16384;
    bf16* AFb = (bf16*)(ws + WS_AF) + (size_t)u * 4096; bf16* VTFb = (bf16*)(ws + WS_VTF) + (size_t)u * 32768; float* EBb = (float*)(ws + WS_EB) + (size_t)u * 256;
    const int tid = otid(), lane = tid & 63, d = tid & 255, half = tid >> 8;
    { const int t = tid >> 3, r2 = tid & 7; unsigned w = 0u; if (t < len) w = *(const unsigned*)(proj + (size_t)(row0 + t) * NPROJ + C_A1 + 2 * r2);
      a1s[t * 16 + 2 * r2] = bflo(w); a1s[t * 16 + 2 * r2 + 1] = bfhi(w); }
    float wa[16];
#pragma unroll
    for (int r = 0; r < 16; ++r) wa[r] = P.in[I_WA2][(size_t)l * RANK * HK + (size_t)r * HK + h * DK + d];
    const float bz = P.in[I_BA2][(size_t)l * HK + h * DK + d];
    __syncthreads();
    float b = 0.f;
    const bf16* src = proj + (size_t)row0 * NPROJ + (half ? C_K : C_Q) + h * DK + d;
    const bf16* vsrc = proj + (size_t)row0 * NPROJ + C_V + h * DV + half * 256 + d;
    for (int tg = 0; tg < 8; ++tg) {
        float val[8]; unsigned vv[8];
#pragma unroll
        for (int j = 0; j < 8; ++j) { const int t = 8 * tg + j;
            if (t < len) {
                const LAS f32x4* ar = (const LAS f32x4*)(a1s + t * 16); const f32x4 a0 = ar[0], a1 = ar[1], a2 = ar[2], a3 = ar[3];
                float z = bz; z += a0.x * wa[0] + a0.y * wa[1] + a0.z * wa[2] + a0.w * wa[3]; z += a1.x * wa[4] + a1.y * wa[5] + a1.z * wa[6] + a1.w * wa[7];
                z += a2.x * wa[8] + a2.y * wa[9] + a2.z * wa[10] + a2.w * wa[11]; z += a3.x * wa[12] + a3.y * wa[13] + a3.z * wa[14] + a3.w * wa[15];
                b += logsigmoidf_(z) * (1.0f / 16.0f);
                const float x = bf2f(src[(size_t)t * NPROJ]);
                val[j] = half ? x * __expf(-b) : x * __expf(b) * (1.0f / 16.0f);
                vv[j] = vsrc[(size_t)t * NPROJ];
            } else { val[j] = 0.f; vv[j] = 0u; }
        }
        u32x4 pk; pk.x = cvt_pk_bf16(val[0], val[1]); pk.y = cvt_pk_bf16(val[2], val[3]); pk.z = cvt_pk_bf16(val[4], val[5]); pk.w = cvt_pk_bf16(val[6], val[7]);
        LAS bf16* dst = (half ? Ks : Qs) + (8 * tg) * 264 + d;
        dst[0 * 264] = (bf16)(pk.x & 0xffff); dst[1 * 264] = (bf16)(pk.x >> 16); dst[2 * 264] = (bf16)(pk.y & 0xffff); dst[3 * 264] = (bf16)(pk.y >> 16);
        dst[4 * 264] = (bf16)(pk.z & 0xffff); dst[5 * 264] = (bf16)(pk.z >> 16); dst[6 * 264] = (bf16)(pk.w & 0xffff); dst[7 * 264] = (bf16)(pk.w >> 16);
        const int lanep = (d & 15) + 16 * (tg & 3), ks = tg >> 2;
        if (half) *(u32x4*)(KTFb + (size_t)((((d >> 4) * 2 + ks) * 64 + lanep) * 8)) = pk;
        u32x4 pv; pv.x = vv[0] | (vv[1] << 16); pv.y = vv[2] | (vv[3] << 16); pv.z = vv[4] | (vv[5] << 16); pv.w = vv[6] | (vv[7] << 16);
        *(u32x4*)(VTFb + (size_t)((((half * 16 + (d >> 4)) * 2 + ks) * 64 + lanep) * 8)) = pv;
    }
    if (half) EBb[d] = __expf(b);
    __syncthreads();
    const int w = F.wave, fr = lane & 15, fq = lane >> 4;
    { const int rt = w >> 1;
#pragma unroll
      for (int i = 0; i < 2; ++i) { const int st = 2 * (w & 1) + i; f32x4 acc = (f32x4){0.f, 0.f, 0.f, 0.f};
          if (st <= rt) {
#pragma unroll
              for (int ks = 0; ks < 8; ++ks) { const bf16x8 a = *(const LAS bf16x8*)(Qs + (16 * rt + fr) * 264 + 32 * ks + 8 * fq); const bf16x8 bb = *(const LAS bf16x8*)(Ks + (16 * st + fr) * 264 + 32 * ks + 8 * fq);
                  acc = __builtin_amdgcn_mfma_f32_16x16x32_bf16(a, bb, acc, 0, 0, 0); } }
#pragma unroll
          for (int reg = 0; reg < 4; ++reg) { const int t = 16 * rt + 4 * fq + reg, s = 16 * st + fr; As[t * 72 + s] = f2bf(s <= t ? acc[reg] : 0.f); } } }
    __syncthreads();
#pragma unroll
    for (int i = 0; i < 4; ++i) { const int f = 4 * w + i, rt = f >> 3, ks = f & 7;
        const u32x2 lo = *(const LAS u32x2*)(Qs + (16 * rt + fr) * 264 + 32 * ks + 4 * fq), hi = *(const LAS u32x2*)(Qs + (16 * rt + fr) * 264 + 32 * ks + 16 + 4 * fq);
        *(u32x4*)(QFb + (size_t)(f * 64 + lane) * 8) = (u32x4){lo.x, lo.y, hi.x, hi.y}; }
    { const int rt = w >> 1, ks = w & 1; *(u32x4*)(AFb + (size_t)(w * 64 + lane) * 8) = *(const LAS u32x4*)(As + (16 * rt + fr) * 72 + 32 * ks + 8 * fq); }
    __syncthreads();
}

__device__ __forceinline__ void gla_prompt_wave(const Params& P, int l, int item, int hw, int lane) {
    unsigned char* ws = P.ws;
    const int n = item >> 6, h = (item >> 4) & 3, vs = item & 15, dvt = 2 * vs + hw;
    const int fr = lane & 15, fq = lane >> 4;
    f32x4 S[16];
#pragma unroll
    for (int i = 0; i < 16; ++i) S[i] = (f32x4){0.f, 0.f, 0.f, 0.f};
    float* OB = (float*)(ws + WS_OB);
    for (int c = 0; c < NCHUNK; ++c) {
        const int ci = n * NCHUNK + c, u = ci * NH + h;
        const int tok0 = (c == 0) ? 0 : NMETA + 64 * (c - 1), len = (c == 0) ? NMETA : 64, row0 = n * LP + tok0;
        const bf16* QFb = (const bf16*)(ws + WS_QF) + (size_t)u * 16384 + lane * 8; const bf16* KTFb = (const bf16*)(ws + WS_KTF) + (size_t)u * 16384 + lane * 8;
        const bf16* AFb = (const bf16*)(ws + WS_AF) + (size_t)u * 4096 + lane * 8; const bf16* VTFb = (const bf16*)(ws + WS_VTF) + (size_t)u * 32768 + (size_t)dvt * 1024 + lane * 8;
        const float* EBb = (const float*)(ws + WS_EB) + (size_t)u * 256 + 4 * fq;
        const bf16x8 vf0 = *(const bf16x8*)(VTFb), vf1 = *(const bf16x8*)(VTFb + 512);
        bf16x8 sf[8];
#pragma unroll
        for (int ks = 0; ks < 8; ++ks) { u32x4 p; p.x = cvt_pk_bf16(S[2 * ks][0], S[2 * ks][1]); p.y = cvt_pk_bf16(S[2 * ks][2], S[2 * ks][3]); p.z = cvt_pk_bf16(S[2 * ks + 1][0], S[2 * ks + 1][1]); p.w = cvt_pk_bf16(S[2 * ks + 1][2], S[2 * ks + 1][3]);
            sf[ks] = __builtin_bit_cast(bf16x8, p); }
#pragma unroll
        for (int rt = 0; rt < 4; ++rt) {
            f32x4 acc = (f32x4){0.f, 0.f, 0.f, 0.f};
#pragma unroll
            for (int ks = 0; ks < 8; ++ks) { const bf16x8 q = *(const bf16x8*)(QFb + (rt * 8 + ks) * 512); acc = __builtin_amdgcn_mfma_f32_16x16x32_bf16(q, sf[ks], acc, 0, 0, 0); }
            { const bf16x8 a0 = *(const bf16x8*)(AFb + (rt * 2 + 0) * 512), a1 = *(const bf16x8*)(AFb + (rt * 2 + 1) * 512);
              acc = __builtin_amdgcn_mfma_f32_16x16x32_bf16(a0, vf0, acc, 0, 0, 0); acc = __builtin_amdgcn_mfma_f32_16x16x32_bf16(a1, vf1, acc, 0, 0, 0); }
#pragma unroll
            for (int reg = 0; reg < 4; ++reg) { const int t = 16 * rt + 4 * fq + reg; if (t < len) OB[(size_t)(row0 + t) * HV + h * DV + dvt * 16 + fr] = acc[reg]; }
        }
#pragma unroll
        for (int dt = 0; dt < 16; ++dt) {
            const bf16x8 k0 = *(const bf16x8*)(KTFb + (dt * 2 + 0) * 512), k1 = *(const bf16x8*)(KTFb + (dt * 2 + 1) * 512);
            f32x4 s = S[dt];
            s = __builtin_amdgcn_mfma_f32_16x16x32_bf16(k0, vf0, s, 0, 0, 0); s = __builtin_amdgcn_mfma_f32_16x16x32_bf16(k1, vf1, s, 0, 0, 0);
            const f32x4 e = *(const f32x4*)(EBb + 16 * dt);
            S[dt] = s * e;
        }
    }
    float* gp = P.out + O_GP + ((size_t)((l * NB + n) * NH + h) * DK) * DV + dvt * 16 + fr;
#pragma unroll
    for (int dt = 0; dt < 16; ++dt)
#pragma unroll
        for (int reg = 0; reg < 4; ++reg) gp[(size_t)(16 * dt + 4 * fq + reg) * DV] = S[dt][reg];
}

__device__ __forceinline__ void gla_sample_wave(const Params& P, int l, int item, LAS float* wl, int lane) {
    unsigned char* ws = P.ws;
    const bf16* proj = (const bf16*)(ws + WS_PROJ);
    const int n = item >> 4, h = (item >> 2) & 3, dvq = item & 3, row0 = NPROMPT + DECS * n;
    LAS float* qs = wl; LAS float* ks = wl + 1024; LAS float* eb = wl + 2048;
    float a1v[4][16];
#pragma unroll
    for (int t = 0; t < 4; ++t)
#pragma unroll
        for (int r = 0; r < 8; ++r) { const unsigned w = *(const unsigned*)(proj + (size_t)(row0 + t) * NPROJ + C_A1 + 2 * r); a1v[t][2 * r] = bflo(w); a1v[t][2 * r + 1] = bfhi(w); }
    float Ap[4][4];
#pragma unroll
    for (int t = 0; t < 4; ++t)
#pragma unroll
        for (int s = 0; s < 4; ++s) Ap[t][s] = 0.f;
#pragma unroll
    for (int i = 0; i < 4; ++i) {
        const int d = lane + 64 * i, col = h * DK + d;
        float z[4]; const float bz = P.in[I_BA2][(size_t)l * HK + col];
#pragma unroll
        for (int t = 0; t < 4; ++t) z[t] = bz;
#pragma unroll
        for (int r = 0; r < 16; ++r) { const float w = P.in[I_WA2][(size_t)l * RANK * HK + (size_t)r * HK + col];
#pragma unroll
            for (int t = 0; t < 4; ++t) z[t] += a1v[t][r] * w; }
        float b = 0.f, qv[4], kv[4];
#pragma unroll
        for (int t = 0; t < 4; ++t) { b += logsigmoidf_(z[t]) * (1.0f / 16.0f);
            qv[t] = bf2f(proj[(size_t)(row0 + t) * NPROJ + C_Q + col]) * __expf(b) * (1.0f / 16.0f);
            kv[t] = bf2f(proj[(size_t)(row0 + t) * NPROJ + C_K + col]) * __expf(-b);
            qs[t * 256 + d] = qv[t]; ks[t * 256 + d] = kv[t]; }
        eb[d] = __expf(b);
#pragma unroll
        for (int t = 0; t < 4; ++t)
#pragma unroll
            for (int s = 0; s < 4; ++s) if (s <= t) Ap[t][s] += qv[t] * kv[s];
    }
#pragma unroll
    for (int t = 0; t < 4; ++t)
#pragma unroll
        for (int s = 0; s < 4; ++s) if (s <= t) Ap[t][s] = wave_sum(Ap[t][s]);
    LDS_WAIT();
    const int cl = 4 * (lane & 31), p = lane >> 5;
    f32x4 vv[4];
#pragma unroll
    for (int s = 0; s < 4; ++s) { const u32x2 w = *(const u32x2*)(proj + (size_t)(row0 + s) * NPROJ + C_V + h * DV + dvq * 128 + cl); vv[s] = (f32x4){bflo(w.x), bfhi(w.x), bflo(w.y), bfhi(w.y)}; }
    f32x4 oacc[4];
#pragma unroll
    for (int t = 0; t < 4; ++t) oacc[t] = (f32x4){0.f, 0.f, 0.f, 0.f};
    const size_t sbase = ((size_t)((l * DECB + n) * NH + h) * DK) * DV + dvq * 128 + cl;
    const float* Sin = P.in[I_SGLA] + sbase; float* Sout = P.out + O_GS + sbase;
#pragma unroll 1
    for (int i0 = 0; i0 < 128; i0 += 8) {
        f32x4 s4[8];
#pragma unroll
        for (int j = 0; j < 8; ++j) s4[j] = *(const f32x4*)(Sin + (size_t)(2 * (i0 + j) + p) * DV);
#pragma unroll
        for (int j = 0; j < 8; ++j) { const int d = 2 * (i0 + j) + p;
            const float q0 = qs[d], q1 = qs[256 + d], q2 = qs[512 + d], q3 = qs[768 + d], k0 = ks[d], k1 = ks[256 + d], k2 = ks[512 + d], k3 = ks[768 + d], e = eb[d];
            oacc[0] += s4[j] * q0; oacc[1] += s4[j] * q1; oacc[2] += s4[j] * q2; oacc[3] += s4[j] * q3;
            const f32x4 kvs = vv[0] * k0 + vv[1] * k1 + vv[2] * k2 + vv[3] * k3;
            *(f32x4*)(Sout + (size_t)d * DV) = (s4[j] + kvs) * e; }
    }
#pragma unroll
    for (int t = 0; t < 4; ++t) {
        f32x4 o = oacc[t];
        o.x += __shfl_xor(o.x, 32); o.y += __shfl_xor(o.y, 32); o.z += __shfl_xor(o.z, 32); o.w += __shfl_xor(o.w, 32);
#pragma unroll
        for (int s = 0; s < 4; ++s) if (s <= t) o += vv[s] * Ap[t][s];
        if (p == 0) *(f32x4*)((float*)(ws + WS_OB) + (size_t)(row0 + t) * HV + h * DV + dvq * 128 + cl) = o;
    }
    LDS_WAIT();
}

__device__ __forceinline__ void merge_unit(const Params& P, int l, int r0, int nrun, int tpos0, int seqlen, bool prompt, int seq, int h, int lane) {
    unsigned char* ws = P.ws;
    const bf16* proj = (const bf16*)(ws + WS_PROJ);
    const int c = h * DV + 8 * lane;
    float p1[8], p2[8], w0[8], w1[8], w2[8], gn[8];
    { const float* cw = P.in[I_CONVW] + (size_t)l * 3 * DM + c; const f32x4 a0 = *(const f32x4*)(cw), a1 = *(const f32x4*)(cw + 4), b0 = *(const f32x4*)(cw + DM), b1 = *(const f32x4*)(cw + DM + 4), c0 = *(const f32x4*)(cw + 2 * DM), c1 = *(const f32x4*)(cw + 2 * DM + 4);
      const f32x4 g0 = *(const f32x4*)(P.in[I_GNW] + (size_t)l * DV + 8 * lane), g1 = *(const f32x4*)(P.in[I_GNW] + (size_t)l * DV + 8 * lane + 4);
#pragma unroll
      for (int j = 0; j < 4; ++j) { w0[j] = a0[j]; w0[4 + j] = a1[j]; w1[j] = b0[j]; w1[4 + j] = b1[j]; w2[j] = c0[j]; w2[4 + j] = c1[j]; gn[j] = g0[j]; gn[4 + j] = g1[j]; } }
    if (tpos0 == 0) {
        if (prompt) {
#pragma unroll
            for (int j = 0; j < 8; ++j) { p1[j] = 0.f; p2[j] = 0.f; }
        } else {
            const float* sc = P.in[I_SCONV] + ((size_t)(l * DECB + seq) * 2) * DM + c;
            const f32x4 a0 = *(const f32x4*)(sc), a1 = *(const f32x4*)(sc + 4), b0 = *(const f32x4*)(sc + DM), b1 = *(const f32x4*)(sc + DM + 4);
#pragma unroll
            for (int j = 0; j < 4; ++j) { p2[j] = a0[j]; p2[4 + j] = a1[j]; p1[j] = b0[j]; p1[4 + j] = b1[j]; }
        }
    } else {
        const u32x4 c1 = *(const u32x4*)(proj + (size_t)(r0 - 1) * NPROJ + C_CC + c), x1 = *(const u32x4*)(proj + (size_t)(r0 - 1) * NPROJ + C_CX + c);
        const u32x4 c2 = *(const u32x4*)(proj + (size_t)(r0 - 2) * NPROJ + C_CC + c), x2 = *(const u32x4*)(proj + (size_t)(r0 - 2) * NPROJ + C_CX + c);
#pragma unroll
        for (int j = 0; j < 4; ++j) { p1[2 * j] = bflo(c1[j]) * bflo(x1[j]); p1[2 * j + 1] = bfhi(c1[j]) * bfhi(x1[j]); p2[2 * j] = bflo(c2[j]) * bflo(x2[j]); p2[2 * j + 1] = bfhi(c2[j]) * bfhi(x2[j]); }
    }
    for (int t = 0; t < nrun; ++t) {
        const size_t row = (size_t)(r0 + t);
        const bf16* pr = proj + row * NPROJ + c;
        const u32x4 vcb = *(const u32x4*)(pr + C_CB), vcc = *(const u32x4*)(pr + C_CC), vcx = *(const u32x4*)(pr + C_CX), vg = *(const u32x4*)(pr + C_G), vga = *(const u32x4*)(pr + C_GA), vgb = *(const u32x4*)(pr + C_GB);
        const float* orow = (const float*)(ws + WS_OB) + row * HV + c;
        const f32x4 o0 = *(const f32x4*)(orow), o1 = *(const f32x4*)(orow + 4);
        float ss = (o0.x * o0.x + o0.y * o0.y) + (o0.z * o0.z + o0.w * o0.w) + (o1.x * o1.x + o1.y * o1.y) + (o1.z * o1.z + o1.w * o1.w);
        ss = wave_sum(ss);
        const float rstd = 1.0f / sqrtf(ss * (1.0f / DV) + LN_EPS);
        float m[8], pn[8];
#pragma unroll
        for (int j = 0; j < 8; ++j) {
            const int q = j >> 1; const bool hi = j & 1;
            const float cb = hi ? bfhi(vcb[q]) : bflo(vcb[q]), cc = hi ? bfhi(vcc[q]) : bflo(vcc[q]), cx = hi ? bfhi(vcx[q]) : bflo(vcx[q]);
            const float g = hi ? bfhi(vg[q]) : bflo(vg[q]), ga = hi ? bfhi(vga[q]) : bflo(vga[q]), gb = hi ? bfhi(vgb[q]) : bflo(vgb[q]);
            const float o = (j < 4) ? o0[j & 3] : o1[j & 3];
            const float pc = cc * cx; pn[j] = pc;
            const float conv = w0[j] * p2[j] + w1[j] * p1[j] + w2[j] * pc;
            const float ya = cb * conv;
            const float yb = o * rstd * gn[j] * (g * sigmoidf_(g));
            m[j] = sigmoidf_(ga) * ya + sigmoidf_(gb) * yb;
            p2[j] = p1[j]; p1[j] = pc;
        }
        u32x4 mo; mo.x = cvt_pk_bf16(m[0], m[1]); mo.y = cvt_pk_bf16(m[2], m[3]); mo.z = cvt_pk_bf16(m[4], m[5]); mo.w = cvt_pk_bf16(m[6], m[7]);
        *(u32x4*)((bf16*)(ws + WS_MB) + row * DM + c) = mo;
        const int tp = tpos0 + t;
        if (tp >= seqlen - 2) {
            float* cs = prompt ? P.out + O_CP + ((size_t)(l * NB + seq) * 2 + (tp - (seqlen - 2))) * DM + c : P.out + O_CS + ((size_t)(l * DECB + seq) * 2 + (tp - (seqlen - 2))) * DM + c;
            *(f32x4*)(cs) = (f32x4){pn[0], pn[1], pn[2], pn[3]}; *(f32x4*)(cs + 4) = (f32x4){pn[4], pn[5], pn[6], pn[7]};
        }
    }
}

__global__ void __launch_bounds__(512, 2) hybrid_fwd(Params P) {
    extern __shared__ __attribute__((aligned(16))) unsigned char lds_raw[];
    Frame F;
    F.lds = (LAS unsigned char*)lds_raw;
    F.wave = __builtin_amdgcn_readfirstlane((int)threadIdx.x >> 6);
    F.G = gridDim.x; { const int bx = blockIdx.x; F.vcu = (F.G % 8 == 0) ? (bx % 8) * (F.G / 8) + bx / 8 : bx; }
    unsigned char* ws = P.ws;
    for (int u = threadIdx.x; u < (LDS_BYTES - LDSCTL_OFF) / 4; u += 512) ((LAS unsigned*)(F.lds + LDSCTL_OFF))[u] = 0u;
    __syncthreads();
    XcdBarrier bar = xcd_barrier_post((unsigned*)(ws + WS_CTL) + CW_BAR, (volatile LAS unsigned*)(F.lds + MISC_OFF) + 8);
    const int gw = F.vcu * 8 + F.wave, NGW = F.G * 8;
#define GRID_BAR() xcd_barrier(bar)

#if DBG_STAGE < 99
    { const size_t gt = (size_t)blockIdx.x * 512 + otid(), NGT = (size_t)F.G * 512; f32x4* o4 = (f32x4*)P.out; for (size_t i = gt; i < O_END / 4; i += NGT) o4[i] = (f32x4){0.f, 0.f, 0.f, 0.f}; }
    GRID_BAR();
#endif
#if !defined(EN) || (EN & 1)
    p0_prologue(F, P);
#endif
    GRID_BAR();

#pragma unroll
    for (int l = 0; l < DEPTH; ++l) {
        if (DBG_STAGE < 99 && l > 0 && DBG_STAGE < 10) break;
        { pg8::Gemm g{(const bf16*)(ws + WS_HB), (const bf16*)(ws + WS_WIN) + (size_t)l * NPROJ * DM, MP, NPROJ, DM}; pg8::StaticOrder S; S.init(MP, NPROJ, F.G, (int)blockIdx.x);
          pg8::EpiBf16<0> E{(bf16*)(ws + WS_PROJ), NPROJ};
          pg8::gemm_phase<pg8::EpiBf16<0>, pg8::StaticOrder, true, true>(F.lds, g, S, E); }
        GRID_BAR();
        if (DBG_STAGE >= 2) {
#if !defined(EN) || (EN & 2)
        for (int uu = blockIdx.x; uu < NPCH * NH; uu += F.G) gla_prep_unit(F, P, l, uu >> 2, uu & 3);
#endif
        GRID_BAR();
#if !defined(EN) || (EN & 4)
        { const int lane = otid() & 63;
        if (F.wave < 2) { for (int it = blockIdx.x; it < NB * NH * 16; it += F.G) gla_prompt_wave(P, l, it, F.wave, lane); }
        else { LAS float* wl = (LAS float*)(F.lds + (F.wave - 2) * 9216); for (int it = blockIdx.x * 6 + (F.wave - 2); it < DECB * NH * 4; it += F.G * 6) gla_sample_wave(P, l, it, wl, lane); } }
#endif
        GRID_BAR();
        }
        { constexpr int RUN = 16, NRUN_P = LP / RUN  , NU_P = NB * NRUN_P * NH, NU_S = DECB * NH; const int lane = otid() & 63;
          for (int uu = gw; uu < NU_P + NU_S; uu += NGW) {
              if (uu < NU_P) { const int h = uu & 3, rr = uu >> 2, b = rr / NRUN_P, ri = rr % NRUN_P; merge_unit(P, l, b * LP + ri * RUN, RUN, ri * RUN, LP, true, b, h, lane); }
              else { const int v = uu - NU_P, h = v & 3, n = v >> 2; merge_unit(P, l, NPROMPT + n * DECS, DECS, 0, DECS, false, n, h, lane); } } }
        GRID_BAR();
        if (DBG_STAGE < 3) continue;
        { pg8::Gemm g{(const bf16*)(ws + WS_MB), (const bf16*)(ws + WS_WO) + (size_t)l * DM * DM, MP, DM, DM}; pg8::StaticOrder S; S.init(MP, DM, F.G, (int)blockIdx.x);
          pg8::EpiResF32 E{(float*)(ws + WS_TF), (const float*)(ws + WS_HF), DM, ALPHA};
          pg8::gemm_phase<pg8::EpiResF32, pg8::StaticOrder, true, true>(F.lds, g, S, E); }
        GRID_BAR();
        { const int lane = otid() & 63; for (int m = gw; m < NTOK; m += NGW) ln_row((const float*)(ws + WS_TF) + (size_t)m * DM, P.in[I_LN1W] + (size_t)l * DM, P.in[I_LN1B] + (size_t)l * DM, (float*)(ws + WS_HF) + (size_t)m * DM, (bf16*)(ws + WS_HB) + (size_t)m * DM, lane); }
        GRID_BAR();
        { pg8::Gemm g{(const bf16*)(ws + WS_HB), (const bf16*)(ws + WS_W1) + (size_t)l * DFF * DM, MP, DFF, DM}; pg8::StaticOrder S; S.init(MP, DFF, F.G, (int)blockIdx.x);
          pg8::EpiBf16<1> E{(bf16*)(ws + WS_RB), DFF};
          pg8::gemm_phase<pg8::EpiBf16<1>, pg8::StaticOrder, true, true>(F.lds, g, S, E); }
        GRID_BAR();
        { pg8::Gemm g{(const bf16*)(ws + WS_RB), (const bf16*)(ws + WS_W2) + (size_t)l * DM * DFF, MP, DM, DFF}; pg8::StaticOrder S; S.init(MP, DM, F.G, (int)blockIdx.x);
          pg8::EpiResF32 E{(float*)(ws + WS_TF), (const float*)(ws + WS_HF), DM, ALPHA};
          pg8::gemm_phase<pg8::EpiResF32, pg8::StaticOrder, true, true>(F.lds, g, S, E); }
        GRID_BAR();
        { const int lane = otid() & 63;
        for (int m = gw; m < NTOK; m += NGW) {
            const float* src = (const float*)(ws + WS_TF) + (size_t)m * DM; const float* lw = P.in[I_LN2W] + (size_t)l * DM; const float* lb = P.in[I_LN2B] + (size_t)l * DM;
            if (l < DEPTH - 1) ln_row(src, lw, lb, (float*)(ws + WS_HF) + (size_t)m * DM, (bf16*)(ws + WS_HB) + (size_t)m * DM, lane);
            else { float* dst;
                if (m < NPROMPT) { const int b = m / LP, t = m % LP; if (t < NMETA) continue; dst = P.out + O_YP + ((size_t)b * SEQ + (t - NMETA)) * DM; }
                else dst = P.out + O_YS + (size_t)(m - NPROMPT) * DM;
                ln_row(src, lw, lb, dst, nullptr, lane); }
        } }
        if (l < DEPTH - 1) GRID_BAR();
    }
}

extern "C" void kernel_launch(void* const* d_in, const int* in_sizes, int n_in, void* d_out, int out_size, void* d_ws, size_t ws_size, hipStream_t stream) {
    static int grid = 0;
    if (grid == 0) {
        if (n_in != 19 || (size_t)out_size != O_END || ws_size < WS_END) { fprintf(stderr, "kernel_launch: unexpected shapes n_in %d out %d ws %zu\n", n_in, out_size, ws_size); grid = -1; return; }
        int dev = 0, cus = 0, per_cu = 0;
        if (hipGetDevice(&dev) != hipSuccess || hipDeviceGetAttribute(&cus, hipDeviceAttributeMultiprocessorCount, dev) != hipSuccess) { grid = -1; return; }
        if (hipFuncSetAttribute((const void*)hybrid_fwd, hipFuncAttributeMaxDynamicSharedMemorySize, LDS_BYTES) != hipSuccess) { fprintf(stderr, "kernel_launch: hipFuncSetAttribute failed\n"); grid = -1; return; }
        if (hipOccupancyMaxActiveBlocksPerMultiprocessor(&per_cu, (const void*)hybrid_fwd, 512, LDS_BYTES) != hipSuccess || per_cu < 1) fprintf(stderr, "kernel_launch: occupancy query says %d\n", per_cu);
        (void)hipGetLastError();
        grid = cus;
    }
    if (grid < 0) return;
    if (hipMemsetAsync((char*)d_ws + WS_CTL, 0, CTL_ZERO_BYTES, stream) != hipSuccess) return;
    Params p{};
    for (int i = 0; i < 19; ++i) p.in[i] = (const float*)d_in[i];
    p.out = (float*)d_out; p.ws = (unsigned char*)d_ws; p.dbg = 0; p.pad = 0;
    hipLaunchKernelGGL(hybrid_fwd, dim3(grid), dim3(512), LDS_BYTES, stream, p);
}
```

```cpp
#include <hip/hip_runtime.h>
#include <cstdio>
#include <cstdint>

#define GAS __attribute__((address_space(1)))
#define LAS __attribute__((address_space(3)))
typedef unsigned short bf16;
typedef short bf16x8 __attribute__((ext_vector_type(8)));
typedef float f32x4 __attribute__((ext_vector_type(4)));
typedef float f32x2 __attribute__((ext_vector_type(2)));
typedef unsigned u32x4 __attribute__((ext_vector_type(4)));
typedef unsigned u32x2 __attribute__((ext_vector_type(2)));

#ifndef DBG_STAGE
#define DBG_STAGE 99
#endif
#ifndef PROBE_REP
#define PROBE_REP 0
#endif
#ifndef STAMP_Q
#define STAMP_Q 16.0f
#endif
#ifndef STAMP_A
#define STAMP_A -1
#endif
#ifndef STAMP_B
#define STAMP_B -1
#endif
#define REP(bit) for (int rep_ = 0; rep_ < 1 + ((PROBE_REP >> (bit)) & 1); ++rep_)

constexpr int DM = 2048, NB = 4, SEQ = 2048, NMETA = 16, LP = SEQ + NMETA, NPROMPT = NB * LP;
constexpr int DECB = 128, DECS = 4, NSAMP = DECB * DECS, NTOK = NPROMPT + NSAMP, MP = 8960;
constexpr int DEPTH = 2, NH = 4, DK = 256, DV = 512, HK = 1024, HV = 2048, RANK = 16, DFF = 8192;
constexpr int DIN = 16400, NPROJ = 16640;
constexpr int W_A1 = 16384;
constexpr int QP = 4352, C_Q = 0, C_K = 1024, C_V = 2048, C_A1 = 4096;
constexpr int NCHUNK = 33, NPCH = NB * NCHUNK;
constexpr float LN_EPS = 1e-5f;
constexpr float ALPHA = 1.41421356237f;
constexpr size_t O_YP = 0, O_YS = 16777216, O_CP = 17825792, O_GP = 17858560, O_CS = 22052864, O_GS = 23101440, O_END = 157319168;

constexpr size_t MiB = 1u << 20;
constexpr size_t WS_CTL = 0, CTL_ZERO_BYTES = 1 * MiB;
constexpr size_t WS_WIN = 1 * MiB, WS_WO = 131 * MiB, WS_W1 = 147 * MiB, WS_W2 = 211 * MiB;
constexpr size_t WS_PB = 450 * MiB, WS_GCB = 485 * MiB, WS_GGB = 520 * MiB, WS_QKV = 555 * MiB;
constexpr size_t WS_HF = 275 * MiB, WS_HB = 345 * MiB, WS_TF = 380 * MiB, WS_PROJ = 450 * MiB, WS_MB = 735 * MiB, WS_RB = 770 * MiB, WS_OB = 910 * MiB;
constexpr size_t WS_QF = 980 * MiB, WS_KTF = 997 * MiB, WS_AF = 1014 * MiB, WS_VTF = 1019 * MiB, WS_EB = 1052 * MiB, WS_PART = 1053 * MiB  , WS_END = 1101 * MiB;
constexpr int CW_BAR = 4096, CW_QUEUE = 8192, CW_STAMP = 12288;
constexpr int CW_TMO = 64;
constexpr int CW_CHK = 16384, CW_CHK_L = 40960;
constexpr int CW_PREP = 131072, CW_PREP_L = 1024;
constexpr int CW_SMP = 98304, CW_SMP_L = 8192;

constexpr int RING_BYTES = 131072, LDSCTL_OFF = 139264  , MISC_OFF = LDSCTL_OFF + 320, LDS_BYTES = 147456;

#define LDS_WAIT() asm volatile("s_waitcnt lgkmcnt(0)" ::: "memory")
#define VM_WAIT() asm volatile("s_waitcnt vmcnt(0)" ::: "memory")
__device__ __forceinline__ unsigned cvt_pk_bf16(float lo, float hi) { unsigned r; asm volatile("v_cvt_pk_bf16_f32 %0, %1, %2" : "=v"(r) : "v"(lo), "v"(hi)); return r; }
__device__ __forceinline__ float bf2f(unsigned u16v) { return __uint_as_float(u16v << 16); }
__device__ __forceinline__ float bflo(unsigned w) { return __uint_as_float(w << 16); }
__device__ __forceinline__ float bfhi(unsigned w) { return __uint_as_float(w & 0xffff0000u); }
__device__ __forceinline__ bf16 f2bf(float f) { unsigned u = __float_as_uint(f); return (bf16)((u + 0x7fffu + ((u >> 16) & 1u)) >> 16); }
__device__ __forceinline__ float wave_sum(float v) {
#pragma unroll
    for (int o = 1; o < 64; o <<= 1) v += __shfl_xor(v, o);
    return v;
}
__device__ __forceinline__ float sigmoidf_(float x) { return 1.0f / (1.0f + __expf(-x)); }
__device__ __forceinline__ float logsigmoidf_(float z) { return fminf(z, 0.f) - __logf(1.0f + __expf(-fabsf(z))); }

namespace pg8 {
#define PG8_LAS __attribute__((address_space(3)))
typedef unsigned short bf16_t;
constexpr int BM = 256, BK = 64, HALF = 128, HTB = HALF * BK * 2, STAGE_BYTES = 8 * HTB, NXCD = 8, WGM = 8;
__host__ __device__ __forceinline__ int lds_byte(int r, int c) { const int st = (r >> 4) * 2 + (c >> 5), rr = r & 15, cc = c & 31, ob = rr * 64 + cc * 2; return st * 1024 + (ob ^ (((ob >> 9) & 1) << 5)); }
__host__ __device__ __forceinline__ void stage_rc(int b, int& R, int& C) { const int st = b / 1024, sb = b % 1024, swz = sb ^ (((sb >> 9) & 1) << 5); R = (st >> 1) * 16 + swz / 64; C = (st & 1) * 32 + (swz % 64) / 2; }
__host__ __device__ __forceinline__ int perm32(int rho) { const int n = rho >> 4, i = rho & 15; return 8 * (i >> 2) + 4 * n + (i & 3); }
struct Unit { int pm, pn, kb, kn, part; };
struct Gemm { const bf16_t* A; const bf16_t* Bt; int M, N, K; };
struct StaticOrder {
    int nM, nN, nwg, G, c, nt;
    __host__ __device__ void init(int M, int N, int K, int G_, int c_) { nM = M / BM; nN = N / BM; nwg = nM * nN; G = G_; c = c_; nt = K / BK; }
    __host__ __device__ bool next(int i, Unit& u) const {
        const long L = (long)i * G + c; if (L >= nwg) return false;
        int wgid = (int)L; { const int q = nwg / NXCD, r = nwg % NXCD, xcd = wgid % NXCD, off = wgid / NXCD; wgid = (xcd < r ? xcd * (q + 1) : r * (q + 1) + (xcd - r) * q) + off; }
        const int nig = WGM * nN, gid = wgid / nig, fm = gid * WGM, gsz = (nM - fm) < WGM ? (nM - fm) : WGM;
        u.pm = fm + ((wgid % nig) % gsz); u.pn = (wgid % nig) / gsz; u.kb = 0; u.kn = nt; u.part = -1; return true;
    }
    __device__ __forceinline__ void a_ready(const Unit&) const {}
    __device__ __forceinline__ void done(const Unit&) const {}
};
struct TailSplitOrder {
    int G, c, nt, nN, nwg;
    __host__ __device__ void init(int M, int N, int K, int G_, int c_) { G = G_; c = c_; nt = K / BK; nN = N / BM; nwg = (M / BM) * nN; }
    __host__ __device__ bool split() const { return G == 256 && nN == 8 && nwg == 280 && (nt % 16) == 0; }
    __host__ __device__ bool next(int i, Unit& u) const {
        if (split()) { const int x = c & 7, j = c >> 3;
            if (i == 0) { u.pm = 4 * x + (j >> 3); u.pn = j & 7; u.kb = 0; u.kn = nt; u.part = -1; return true; }
            if (i == 1 && j < 24) { u.pm = 32 + (j >> 3); u.pn = j & 7; u.kb = x * (nt >> 3); u.kn = nt >> 3; u.part = j * 8 + x; return true; }
            return false; }
        const long L = (long)i * G + c; if (L >= nwg) return false;
        u.pm = (int)(L / nN); u.pn = (int)(L % nN); u.kb = 0; u.kn = nt; u.part = -1; return true;
    }
    __device__ __forceinline__ void a_ready(const Unit&) const {}
    __device__ __forceinline__ void done(const Unit&) const {}
};
template <int ACT  > struct EpiBf16 {
    static constexpr bool PERM = true, AFTER_DRAIN = false;
    bf16_t* O; int ldc;
    __device__ __forceinline__ void operator()(const f32x4 (&acc)[2][2][4][2], const Unit& u, int wr, int wc, int fr, int fq) const {
        const int row0 = u.pm * BM + wr * 64 + fr; const int col0 = u.pn * BM + wc * 32 + 8 * fq;
#pragma unroll
        for (int ai = 0; ai < 2; ++ai)
#pragma unroll
            for (int m = 0; m < 4; ++m) { bf16_t* rowp = O + (size_t)(row0 + ai * HALF + m * 16) * ldc + col0;
#pragma unroll
                for (int bj = 0; bj < 2; ++bj) { f32x4 v0 = acc[ai][bj][m][0], v1 = acc[ai][bj][m][1];
                    if (ACT == 1) {
#pragma unroll
                        for (int j = 0; j < 4; ++j) { const float a = fmaxf(v0[j], 0.f), b = fmaxf(v1[j], 0.f); v0[j] = a * a; v1[j] = b * b; } }
                    u32x4 w; w.x = cvt_pk_bf16(v0[0], v0[1]); w.y = cvt_pk_bf16(v0[2], v0[3]); w.z = cvt_pk_bf16(v1[0], v1[1]); w.w = cvt_pk_bf16(v1[2], v1[3]);
                    *(u32x4*)(rowp + bj * HALF) = w; } }
    }
};
struct EpiInProj {
    static constexpr bool PERM = true, AFTER_DRAIN = false;
    bf16_t* PB; bf16_t* GCB; bf16_t* GGB; bf16_t* QKV; int qp;
    __device__ __forceinline__ static float sig(float x) { return __builtin_amdgcn_rcpf(1.0f + __expf(-x)); }
    __device__ __forceinline__ void operator()(const f32x4 (&acc)[2][2][4][2], const Unit& u, int wr, int wc, int fr, int fq) const {
        const int row0 = u.pm * BM + wr * 64 + fr;
        if (u.pn >= 48) {
            const int col0 = (u.pn - 48) * BM + wc * 32 + 8 * fq;
#pragma unroll
            for (int ai = 0; ai < 2; ++ai)
#pragma unroll
                for (int m = 0; m < 4; ++m) { bf16_t* rowp = QKV + (size_t)(row0 + ai * HALF + m * 16) * qp + col0;
#pragma unroll
                    for (int bj = 0; bj < 2; ++bj) { const f32x4 v0 = acc[ai][bj][m][0], v1 = acc[ai][bj][m][1];
                        u32x4 w; w.x = cvt_pk_bf16(v0[0], v0[1]); w.y = cvt_pk_bf16(v0[2], v0[3]); w.z = cvt_pk_bf16(v1[0], v1[1]); w.w = cvt_pk_bf16(v1[2], v1[3]);
                        *(u32x4*)(rowp + bj * HALF) = w; } }
            return; }
        const int type = u.pn >> 4, col0 = (u.pn & 15) * HALF + wc * 32 + 8 * fq;
#define EIP_TILE(O_, EXPR_) do { _Pragma("unroll") for (int ai = 0; ai < 2; ++ai) _Pragma("unroll") for (int m = 0; m < 4; ++m) { float r[8]; \
            _Pragma("unroll") for (int n = 0; n < 2; ++n) _Pragma("unroll") for (int j = 0; j < 4; ++j) { const float x = acc[ai][0][m][n][j], y = acc[ai][1][m][n][j]; r[4 * n + j] = (EXPR_); } \
            u32x4 w; w.x = cvt_pk_bf16(r[0], r[1]); w.y = cvt_pk_bf16(r[2], r[3]); w.z = cvt_pk_bf16(r[4], r[5]); w.w = cvt_pk_bf16(r[6], r[7]); \
            *(u32x4*)((O_) + (size_t)(row0 + ai * HALF + m * 16) * 2048 + col0) = w; } } while (0)
        if (type == 0) EIP_TILE(PB, x * y);
        else if (type == 1) EIP_TILE(GCB, x * sig(y));
        else EIP_TILE(GGB, x * sig(x) * sig(y));
#undef EIP_TILE
    }
};
struct EpiResBf16 {
    static constexpr bool PERM = true, AFTER_DRAIN = false;
    bf16_t* T; const bf16_t* res; int ldc; float alpha; float* part_buf;
    __device__ __forceinline__ void operator()(const f32x4 (&acc)[2][2][4][2], const Unit& u, int wr, int wc, int fr, int fq) const {
        const int lrow0 = wr * 64 + fr, lcol0 = wc * 32 + 8 * fq;
        const int row0 = u.pm * BM + lrow0, col0 = u.pn * BM + lcol0;
        const bool withres = (u.part < 0) || (u.kb == 0);
        bf16_t* pb = (bf16_t*)part_buf + (size_t)(u.part < 0 ? 0 : u.part) * 65536;
#pragma unroll
        for (int ai = 0; ai < 2; ++ai)
#pragma unroll
            for (int m = 0; m < 4; ++m) { const size_t off = (size_t)(row0 + ai * HALF + m * 16) * ldc + col0; const int loff = (lrow0 + ai * HALF + m * 16) * 256 + lcol0;
#pragma unroll
                for (int bj = 0; bj < 2; ++bj) { f32x4 v0 = acc[ai][bj][m][0], v1 = acc[ai][bj][m][1];
                    if (withres) { const u32x4 r = *(const u32x4*)(res + off + bj * HALF);
                        v0 += (f32x4){__uint_as_float(r.x << 16), __uint_as_float(r.x & 0xffff0000u), __uint_as_float(r.y << 16), __uint_as_float(r.y & 0xffff0000u)} * alpha;
                        v1 += (f32x4){__uint_as_float(r.z << 16), __uint_as_float(r.z & 0xffff0000u), __uint_as_float(r.w << 16), __uint_as_float(r.w & 0xffff0000u)} * alpha; }
                    u32x4 w; w.x = cvt_pk_bf16(v0[0], v0[1]); w.y = cvt_pk_bf16(v0[2], v0[3]); w.z = cvt_pk_bf16(v1[0], v1[1]); w.w = cvt_pk_bf16(v1[2], v1[3]);
                    if (u.part >= 0) *(u32x4*)(pb + loff + bj * HALF) = w; else *(u32x4*)(T + off + bj * HALF) = w; } }
    }
};
struct EpiResF32 {
    static constexpr bool PERM = false, AFTER_DRAIN = false;
    float* C; const float* res; int ldc; float alpha; float* part_buf;
    __device__ __forceinline__ void operator()(const f32x4 (&acc)[2][2][4][2], const Unit& u, int wr, int wc, int fr, int fq) const {
        const int lrow0 = wr * 64 + fr, lcol0 = wc * 32 + 4 * fq;
        const int row0 = u.pm * BM + lrow0, col0 = u.pn * BM + lcol0;
        if (u.part >= 0) {
            float* pb = part_buf + (size_t)u.part * 65536; const float a0 = (u.kb == 0) ? alpha : 0.f;
#pragma unroll
            for (int ai = 0; ai < 2; ++ai)
#pragma unroll
                for (int m = 0; m < 4; ++m) { const size_t off = (size_t)(row0 + ai * HALF + m * 16) * ldc + col0; const int loff = (lrow0 + ai * HALF + m * 16) * 256 + lcol0;
#pragma unroll
                    for (int bj = 0; bj < 2; ++bj)
#pragma unroll
                        for (int n = 0; n < 2; ++n) { f32x4 v = acc[ai][bj][m][n]; if (u.kb == 0) { const f32x4 r = *(const f32x4*)(res + off + bj * HALF + n * 16); v = r * a0 + v; } *(f32x4*)(pb + loff + bj * HALF + n * 16) = v; } }
            return; }
#pragma unroll
        for (int ai = 0; ai < 2; ++ai)
#pragma unroll
            for (int m = 0; m < 4; ++m) { const size_t off = (size_t)(row0 + ai * HALF + m * 16) * ldc + col0;
#pragma unroll
                for (int bj = 0; bj < 2; ++bj)
#pragma unroll
                    for (int n = 0; n < 2; ++n) { const f32x4 r = *(const f32x4*)(res + off + bj * HALF + n * 16); *(f32x4*)(C + off + bj * HALF + n * 16) = r * alpha + acc[ai][bj][m][n]; } }
    }
};

template <class Epi, class Sched, bool ALIGN_EPI = false, bool SP2 = false, bool SERP = false>
__device__ __forceinline__ void gemm_phase(PG8_LAS unsigned char* lds, const Gemm g, const Sched& S, const Epi& E) {
    int tid_ = threadIdx.x; asm volatile("" : "+v"(tid_));
    const int tid = tid_, wid = __builtin_amdgcn_readfirstlane(tid >> 6), lane = tid & 63, wr = wid >> 2, wc = wid & 3, fr = lane & 15, fq = lane >> 4;
    const int K = g.K;
    unsigned voffA[2], voffB[2];
#pragma unroll
    for (int i = 0; i < 2; ++i) { int R, C; stage_rc(tid * 16 + i * 8192, R, C); const int Rb = Epi::PERM ? ((R & ~31) + perm32(R & 31)) : R;
        voffA[i] = (unsigned)(R * K + C) * 2u; voffB[i] = (unsigned)(Rb * K + C) * 2u; }
    const size_t kstep = (size_t)(BK * 2);
    const size_t hstep = (size_t)HALF * K * 2;
    const size_t tstep = 2 * hstep;
    const unsigned ldsw = (unsigned)wid * 1024u;
    const int aoff = lds_byte(wr * 64 + fr, fq * 8), boff = lds_byte(wc * 32 + fr, fq * 8);
#define PG8_SA(b, h) (((b) * 2 + (h)) * HTB)
#define PG8_SB(b, h) ((4 + (b) * 2 + (h)) * HTB)
#define PG8_STAGE(bufoff, gbase, voff) do { _Pragma("unroll") for (int _i = 0; _i < 2; ++_i) \
        __builtin_amdgcn_global_load_lds((const unsigned*)((const char*)(gbase) + (voff)[_i]), (PG8_LAS unsigned*)(lds + (bufoff) + ldsw + _i * 8192), 16, 0, 0); } while (0)
#define PG8_LDA(dst, b, h) do { _Pragma("unroll") for (int m = 0; m < 4; ++m) _Pragma("unroll") for (int k = 0; k < 2; ++k) dst[m][k] = *(const PG8_LAS bf16x8*)(lds + PG8_SA(b, h) + aoff + m * 2048 + k * 1024); } while (0)
#define PG8_LDB(dst, b, h) do { _Pragma("unroll") for (int n = 0; n < 2; ++n) _Pragma("unroll") for (int k = 0; k < 2; ++k) dst[n][k] = *(const PG8_LAS bf16x8*)(lds + PG8_SB(b, h) + boff + n * 2048 + k * 1024); } while (0)
#define PG8_MMA(ai, bj, At, Bt) do { __builtin_amdgcn_s_setprio(1); _Pragma("unroll") for (int m = 0; m < 4; ++m) _Pragma("unroll") for (int n = 0; n < 2; ++n) _Pragma("unroll") for (int k = 0; k < 2; ++k) \
        acc[ai][bj][m][n] = __builtin_amdgcn_mfma_f32_16x16x32_bf16(Bt[n][k], At[m][k], acc[ai][bj][m][n], 0, 0, 0); __builtin_amdgcn_s_setprio(0); } while (0)
#define PG8_WAIT_V(n) asm volatile("s_waitcnt vmcnt(" #n ")" ::: "memory")
#define PG8_WAIT_L(n) asm volatile("s_waitcnt lgkmcnt(" #n ")" ::: "memory")
#define PG8_BAR __builtin_amdgcn_s_barrier()
#define PG8_SCHED __builtin_amdgcn_sched_barrier(0)
    Unit cur, nxt; int ui = 0;
    if (!S.next(0, cur)) return;
    f32x4 acc[2][2][4][2];
#pragma unroll
    for (int a = 0; a < 2; ++a)
#pragma unroll
        for (int b = 0; b < 2; ++b)
#pragma unroll
            for (int m = 0; m < 4; ++m)
#pragma unroll
                for (int n = 0; n < 2; ++n) acc[a][b][m][n] = (f32x4){0.f, 0.f, 0.f, 0.f};
    bf16x8 At[4][2], B0[2][2], B1[2][2];
    const char* cA = (const char*)g.A + (size_t)cur.pm * tstep + (size_t)cur.kb * kstep; const char* cB = (const char*)g.Bt + (size_t)cur.pn * tstep + (size_t)cur.kb * kstep;
    S.a_ready(cur);
    if constexpr (SP2) {
        PG8_STAGE(PG8_SB(0, 0), cB, voffB); PG8_STAGE(PG8_SB(0, 1), cB + hstep, voffB); PG8_STAGE(PG8_SA(0, 0), cA, voffA); PG8_STAGE(PG8_SA(0, 1), cA + hstep, voffA);
        if (wr == 1) PG8_BAR;
        PG8_WAIT_V(2); PG8_BAR;
        PG8_STAGE(PG8_SB(1, 0), cB + kstep, voffB); PG8_STAGE(PG8_SA(1, 0), cA + kstep, voffA); PG8_STAGE(PG8_SB(1, 1), cB + hstep + kstep, voffB);
        PG8_WAIT_V(6); PG8_BAR;
    } else {
        PG8_STAGE(PG8_SB(0, 0), cB, voffB); PG8_STAGE(PG8_SA(0, 0), cA, voffA); PG8_STAGE(PG8_SB(0, 1), cB + hstep, voffB); PG8_STAGE(PG8_SA(0, 1), cA + hstep, voffA);
        if (wr == 1) PG8_BAR;
        PG8_WAIT_V(4); PG8_BAR;
        PG8_STAGE(PG8_SB(1, 0), cB + kstep, voffB); PG8_STAGE(PG8_SA(1, 0), cA + kstep, voffA); PG8_STAGE(PG8_SB(1, 1), cB + hstep + kstep, voffB);
        PG8_WAIT_V(6); PG8_BAR;
    }
    for (;;) {
        const bool has_next = S.next(ui + 1, nxt);
        const bool cdn = SERP && (ui & 1), ndn = SERP && !(ui & 1) && has_next;
        const long cst = cdn ? -(long)kstep : (long)kstep, nst = ndn ? -(long)kstep : (long)kstep;
        const size_t nk0 = (size_t)(ndn ? nxt.kb + nxt.kn - 1 : nxt.kb) * kstep;
        const char* nA = has_next ? (const char*)g.A + (size_t)nxt.pm * tstep + nk0 : cA; const char* nB = has_next ? (const char*)g.Bt + (size_t)nxt.pn * tstep + nk0 : cB;
        const int nt = cur.kn;
        for (int t = 0; t < nt; t += 2) {
            const bool last = (t == nt - 2);
            const char* a1 = cA + (long)(t + 1) * cst;
            const char* a2 = last ? nA : cA + (long)(t + 2) * cst; const char* b2 = last ? nB : cB + (long)(t + 2) * cst;
            const long st3 = last ? nst : cst;
            const char* a3 = a2 + st3; const char* b3 = b2 + st3;
            if (last && has_next) S.a_ready(nxt);
            if constexpr (SP2) {
            PG8_LDB(B0, 0, 0); PG8_LDB(B1, 0, 1); PG8_SCHED; PG8_LDA(At, 0, 0); PG8_STAGE(PG8_SA(1, 1), a1 + hstep, voffA);
            PG8_WAIT_V(8); PG8_WAIT_L(0); PG8_BAR; PG8_MMA(0, 0, At, B0); PG8_MMA(0, 1, At, B1); PG8_BAR; PG8_SCHED;
            PG8_LDA(At, 0, 1); PG8_STAGE(PG8_SB(0, 0), b2, voffB); PG8_STAGE(PG8_SB(0, 1), b2 + hstep, voffB); PG8_STAGE(PG8_SA(0, 0), a2, voffA);
            PG8_WAIT_V(8); PG8_WAIT_L(0); PG8_BAR; PG8_MMA(1, 0, At, B0); PG8_MMA(1, 1, At, B1); PG8_BAR; PG8_SCHED;
            PG8_LDB(B0, 1, 0); PG8_LDB(B1, 1, 1); PG8_SCHED; PG8_LDA(At, 1, 0); PG8_STAGE(PG8_SA(0, 1), a2 + hstep, voffA);
            PG8_WAIT_V(8); PG8_WAIT_L(0); PG8_BAR; PG8_MMA(0, 0, At, B0); PG8_MMA(0, 1, At, B1); PG8_BAR; PG8_SCHED;
            PG8_LDA(At, 1, 1); PG8_STAGE(PG8_SB(1, 0), b3, voffB); PG8_STAGE(PG8_SB(1, 1), b3 + hstep, voffB); PG8_STAGE(PG8_SA(1, 0), a3, voffA);
            PG8_WAIT_V(8); PG8_WAIT_L(0); PG8_BAR; PG8_MMA(1, 0, At, B0); PG8_MMA(1, 1, At, B1); PG8_BAR; PG8_SCHED;
            } else {
            PG8_LDB(B0, 0, 0); PG8_SCHED; PG8_LDA(At, 0, 0); PG8_STAGE(PG8_SA(1, 1), a1 + hstep, voffA);
            PG8_WAIT_L(8); PG8_BAR; PG8_WAIT_L(0); PG8_MMA(0, 0, At, B0); PG8_BAR; PG8_SCHED;
            PG8_LDB(B1, 0, 1); PG8_STAGE(PG8_SB(0, 0), b2, voffB);
            PG8_BAR; PG8_WAIT_L(0); PG8_MMA(0, 1, At, B1); PG8_BAR;
            PG8_LDA(At, 0, 1); PG8_STAGE(PG8_SA(0, 0), a2, voffA);
            PG8_BAR; PG8_WAIT_L(0); PG8_MMA(1, 0, At, B0); PG8_BAR; PG8_SCHED;
            PG8_STAGE(PG8_SB(0, 1), b2 + hstep, voffB);
            PG8_WAIT_V(6); PG8_BAR; PG8_MMA(1, 1, At, B1); PG8_BAR;
            PG8_LDB(B0, 1, 0); PG8_SCHED; PG8_LDA(At, 1, 0); PG8_STAGE(PG8_SA(0, 1), a2 + hstep, voffA);
            PG8_WAIT_L(8); PG8_BAR; PG8_WAIT_L(0); PG8_MMA(0, 0, At, B0); PG8_BAR; PG8_SCHED;
            PG8_LDB(B1, 1, 1); PG8_STAGE(PG8_SB(1, 0), b3, voffB);
            PG8_BAR; PG8_WAIT_L(0); PG8_MMA(0, 1, At, B1); PG8_BAR;
            PG8_LDA(At, 1, 1); PG8_STAGE(PG8_SA(1, 0), a3, voffA);
            PG8_BAR; PG8_WAIT_L(0); PG8_MMA(1, 0, At, B0); PG8_BAR; PG8_SCHED;
            PG8_STAGE(PG8_SB(1, 1), b3 + hstep, voffB);
            PG8_WAIT_V(6); PG8_BAR; PG8_MMA(1, 1, At, B1); PG8_BAR;
            }
        }
        if constexpr (ALIGN_EPI) { if (wr == 0) PG8_BAR; }
        if constexpr (!Epi::AFTER_DRAIN) { E(acc, cur, wr, wc, fr, fq); S.done(cur); }
        if (!has_next) break;
#pragma unroll
        for (int a = 0; a < 2; ++a)
#pragma unroll
            for (int b = 0; b < 2; ++b)
#pragma unroll
                for (int m = 0; m < 4; ++m)
#pragma unroll
                    for (int n = 0; n < 2; ++n) acc[a][b][m][n] = (f32x4){0.f, 0.f, 0.f, 0.f};
        cur = nxt; cA = nA; cB = nB; ++ui;
        if constexpr (ALIGN_EPI) { if (wr == 1) PG8_BAR; }
    }
    PG8_WAIT_V(0);
    if constexpr (!ALIGN_EPI) { if (wr == 0) PG8_BAR; }
    PG8_BAR;
#undef PG8_SA
#undef PG8_SB
#undef PG8_STAGE
#undef PG8_LDA
#undef PG8_LDB
#undef PG8_MMA
#undef PG8_WAIT_V
#undef PG8_WAIT_L
#undef PG8_BAR
#undef PG8_SCHED
}
}

#define XB_TMO      128
#define XB_XCNT(j)  (256  + 64 * (j))
#define XB_XSUB(j)  (1280 + 64 * (j))
#define XB_XGEN(j)  (2304 + 64 * (j))
#define XB_TOP      3328
#define XB_TOPGEN   3392
#define XCD_BAR_WORDS 3456
#define XB_SPIN_CAP (1u << 18)
__device__ __forceinline__ unsigned xb_ld(unsigned* p)              { return __hip_atomic_load(p, __ATOMIC_RELAXED, __HIP_MEMORY_SCOPE_AGENT); }
__device__ __forceinline__ unsigned xb_add(unsigned* p, unsigned v) { return __hip_atomic_fetch_add(p, v, __ATOMIC_RELAXED, __HIP_MEMORY_SCOPE_AGENT); }
__device__ __forceinline__ unsigned xb_xcc_id() { return (unsigned)__builtin_amdgcn_s_getreg((3 << 11) | 20) & 0xFu; }
#define XB_SPIN(cond, bar) do { unsigned _sp = 0; while (cond) { __builtin_amdgcn_s_sleep(1); \
    if ((++_sp & 255u) == 0u) { if (xb_ld(&(bar)[XB_TMO])) break; if (_sp > XB_SPIN_CAP) { atomicAdd(&(bar)[XB_TMO], 1u); break; } } } } while (0)
struct XcdBarrier { unsigned* bar; unsigned x; volatile LAS unsigned* st; };
__device__ __forceinline__ XcdBarrier xcd_barrier_post(unsigned* bar, volatile LAS unsigned* st) {
    XcdBarrier b; b.bar = bar; b.x = xb_xcc_id(); b.st = st;
    if (threadIdx.x == 0) (void)xb_add(&bar[XB_XCNT(b.x)], 1u);
    return b;
}
__device__ __forceinline__ void xcd_barrier_complete(unsigned* bar, unsigned x, unsigned& nloc, unsigned& nx) {
    const unsigned G = gridDim.x * gridDim.y * gridDim.z;
    unsigned sum, cnt, mine, sp = 0u;
    for (;;) {
        sum = 0u; cnt = 0u; mine = 0u;
#pragma unroll
        for (unsigned j = 0; j < 16; ++j) { const unsigned c = xb_ld(&bar[XB_XCNT(j)]); sum += c; cnt += (c > 0u) ? 1u : 0u; mine = (j == x) ? c : mine; }
        if (sum == G) break;
        __builtin_amdgcn_s_sleep(1);
        if ((++sp & 255u) == 0u) { if (xb_ld(&bar[XB_TMO])) break; if (sp > XB_SPIN_CAP) { atomicAdd(&bar[XB_TMO], 1u); break; } }
    }
    nloc = mine > 0u ? mine : 1u; nx = cnt > 0u ? cnt : 1u;
}
__device__ __forceinline__ void xcd_barrier(const XcdBarrier& b) {
    asm volatile("s_waitcnt vmcnt(0)" ::: "memory");
    __syncthreads();
    if (threadIdx.x == 0) {
        unsigned* bar = b.bar;
        unsigned bx = b.x; asm volatile("" : "+s"(bx));
        __builtin_amdgcn_s_waitcnt(0);
        unsigned nloc = b.st[0], nx = b.st[1];
        if (nloc == 0u) { xcd_barrier_complete(bar, bx, nloc, nx); b.st[0] = nloc; b.st[1] = nx; }
        const unsigned old = xb_add(&bar[XB_XSUB(bx)], 1u);
        const unsigned gen = old / nloc;
        if (old + 1u == (gen + 1u) * nloc) {
            __builtin_amdgcn_fence(__ATOMIC_RELEASE, "agent");
            asm volatile("s_waitcnt vmcnt(0)" ::: "memory");
            const unsigned og = xb_add(&bar[XB_TOP], 1u);
            const unsigned tg = og / nx;
            if (og + 1u == (tg + 1u) * nx) xb_add(&bar[XB_TOPGEN], 1u);
            else XB_SPIN(xb_ld(&bar[XB_TOPGEN]) == tg, bar);
            __builtin_amdgcn_fence(__ATOMIC_ACQUIRE, "agent");
            xb_add(&bar[XB_XGEN(bx)], 1u);
            asm volatile("s_waitcnt vmcnt(0)" ::: "memory");
        } else {
            XB_SPIN(xb_ld(&bar[XB_XGEN(bx)]) == gen, bar);
            __builtin_amdgcn_fence(__ATOMIC_ACQUIRE, "agent");
            asm volatile("s_waitcnt vmcnt(0)" ::: "memory");
        }
    }
    __syncthreads();
}

struct Params { const float* in[19]; float* out; unsigned char* ws; int dbg; int pad; };
enum { I_XP = 0, I_XS, I_SCONV, I_SGLA, I_META, I_LNW, I_LNB, I_WIN, I_CONVW, I_WA2, I_BA2, I_GNW, I_WO, I_LN1W, I_LN1B, I_W1, I_W2, I_LN2W, I_LN2B };

struct Frame {
    LAS unsigned char* lds;
    int wave, vcu, G;
};
__device__ __forceinline__ int otid() { int t = threadIdx.x; asm volatile("" : "+v"(t)); return t; }

struct CvtItem { const float* src; bf16* dst; int ldw, K; };
__device__ __forceinline__ void cvt_load(const CvtItem& ci, f32x4 (&v)[16], int lane) {
    const int r = lane >> 4, c4 = lane & 15;
#pragma unroll
    for (int i = 0; i < 16; ++i) v[i] = *(const f32x4*)(ci.src + (size_t)(4 * i + r) * ci.ldw + 4 * c4);
}
__device__ __forceinline__ void cvt_store(const CvtItem& ci, const f32x4 (&v)[16], LAS float* scr, int lane) {
    const int r = lane >> 4, c4 = lane & 15;
#pragma unroll
    for (int i = 0; i < 16; ++i) { const int k = 4 * i + r; *(LAS f32x4*)(scr + k * 64 + ((4 * c4) ^ (((k >> 3) & 7) << 2))) = v[i]; }
    LDS_WAIT();
    const int c = lane & 7, nn = lane >> 3;
#pragma unroll
    for (int p = 0; p < 8; ++p) { const int n = 8 * p + nn; const LAS float* s = scr + (8 * c) * 64 + (n ^ (c << 2));
        u32x4 o; o.x = cvt_pk_bf16(s[0], s[64]); o.y = cvt_pk_bf16(s[128], s[192]); o.z = cvt_pk_bf16(s[256], s[320]); o.w = cvt_pk_bf16(s[384], s[448]);
        *(u32x4*)(ci.dst + (size_t)n * ci.K + 8 * c) = o; }
    LDS_WAIT();
}
__device__ __forceinline__ void ln_row(const float* xrow, const float* w, const float* b, float* of, bf16* ob, int lane, const float* part = nullptr) {
    (void)part;
    const f32x4* xr = (const f32x4*)xrow + lane;
    f32x4 wv[8], bv[8];
#pragma unroll
    for (int j = 0; j < 8; ++j) { wv[j] = ((const f32x4*)w)[lane + 64 * j]; bv[j] = ((const f32x4*)b)[lane + 64 * j]; }
    f32x4 v[8]; float s = 0.f;
#pragma unroll
    for (int j = 0; j < 8; ++j) v[j] = xr[64 * j];
#pragma unroll
    for (int j = 0; j < 8; ++j) s += (v[j].x + v[j].y) + (v[j].z + v[j].w);
    const float mean = wave_sum(s) * (1.f / DM); float s2 = 0.f;
#pragma unroll
    for (int j = 0; j < 8; ++j) { v[j] = v[j] - mean; s2 += (v[j].x * v[j].x + v[j].y * v[j].y) + (v[j].z * v[j].z + v[j].w * v[j].w); }
    const float rstd = 1.f / sqrtf(wave_sum(s2) * (1.f / DM) + LN_EPS);
#pragma unroll
    for (int j = 0; j < 8; ++j) { const f32x4 y = v[j] * rstd * wv[j] + bv[j];
        if (of) ((f32x4*)of)[lane + 64 * j] = y;
        if (ob) { u32x2 o; o.x = cvt_pk_bf16(y.x, y.y); o.y = cvt_pk_bf16(y.z, y.w); ((u32x2*)ob)[lane + 64 * j] = o; } }
}

__device__ __forceinline__ void ln_row_bf(const bf16* xrow, const float* w, const float* b, float* of, bf16* ob, int lane, const float* part) {
    f32x4 wv[4][2], bv[4][2];
#pragma unroll
    for (int j = 0; j < 4; ++j) { const int c = 8 * lane + 512 * j; wv[j][0] = *(const f32x4*)(w + c); wv[j][1] = *(const f32x4*)(w + c + 4); bv[j][0] = *(const f32x4*)(b + c); bv[j][1] = *(const f32x4*)(b + c + 4); }
    f32x4 v[4][2]; float s = 0.f;
    if (part) {
#pragma unroll
        for (int j = 0; j < 4; ++j) { const int c = 8 * lane + 512 * j; const bf16* pp = (const bf16*)part + (size_t)((c >> 8) * 8) * 65536 + (c & 255);
            u32x4 r[8];
#pragma unroll
            for (int x = 0; x < 8; ++x) r[x] = *(const u32x4*)(pp + (size_t)x * 65536);
            f32x4 a0 = (f32x4){0.f, 0.f, 0.f, 0.f}, a1 = a0;
#pragma unroll
            for (int x = 0; x < 8; ++x) { a0 += (f32x4){bflo(r[x].x), bfhi(r[x].x), bflo(r[x].y), bfhi(r[x].y)}; a1 += (f32x4){bflo(r[x].z), bfhi(r[x].z), bflo(r[x].w), bfhi(r[x].w)}; }
            v[j][0] = a0; v[j][1] = a1; }
    } else {
        u32x4 r[4];
#pragma unroll
        for (int j = 0; j < 4; ++j) r[j] = *(const u32x4*)(xrow + 8 * lane + 512 * j);
#pragma unroll
        for (int j = 0; j < 4; ++j) { v[j][0] = (f32x4){bflo(r[j].x), bfhi(r[j].x), bflo(r[j].y), bfhi(r[j].y)}; v[j][1] = (f32x4){bflo(r[j].z), bfhi(r[j].z), bflo(r[j].w), bfhi(r[j].w)}; }
    }
#pragma unroll
    for (int j = 0; j < 4; ++j) s += ((v[j][0].x + v[j][0].y) + (v[j][0].z + v[j][0].w)) + ((v[j][1].x + v[j][1].y) + (v[j][1].z + v[j][1].w));
    const float mean = wave_sum(s) * (1.f / DM); float s2 = 0.f;
#pragma unroll
    for (int j = 0; j < 4; ++j)
#pragma unroll
        for (int k = 0; k < 2; ++k) { v[j][k] = v[j][k] - mean; s2 += (v[j][k].x * v[j][k].x + v[j][k].y * v[j][k].y) + (v[j][k].z * v[j][k].z + v[j][k].w * v[j][k].w); }
    const float rstd = 1.f / sqrtf(wave_sum(s2) * (1.f / DM) + LN_EPS);
#pragma unroll
    for (int j = 0; j < 4; ++j) { const int c = 8 * lane + 512 * j;
        const f32x4 y0 = v[j][0] * rstd * wv[j][0] + bv[j][0], y1 = v[j][1] * rstd * wv[j][1] + bv[j][1];
        if (of) { *(f32x4*)(of + c) = y0; *(f32x4*)(of + c + 4) = y1; }
        if (ob) { u32x4 o; o.x = cvt_pk_bf16(y0.x, y0.y); o.y = cvt_pk_bf16(y0.z, y0.w); o.z = cvt_pk_bf16(y1.x, y1.y); o.w = cvt_pk_bf16(y1.z, y1.w); *(u32x4*)(ob + c) = o; } }
}
__device__ __forceinline__ void p0_prologue(const Frame& F, const Params& P) {
    unsigned char* ws = P.ws;
    const int tid = otid(), lane = tid & 63;
    LAS float* scr = (LAS float*)(F.lds + F.wave * 16384);
    const int gw = F.vcu * 8 + F.wave, NGW = F.G * 8;
    constexpr int I_IN = 32 * 256, I_O = 32 * 32, I_1 = 32 * 128, I_2 = 128 * 32, I_L = I_IN + I_O + I_1 + I_2;
#define CVT_DECODE(it_, ci_) do { const int l_ = (it_) / I_L; int r_ = (it_) % I_L; \
        if (r_ < I_IN) { const int kb = r_ >> 8, nb = r_ & 255; const int nd = nb * 64, T_ = nd >> 8, hf_ = (nd >> 7) & 1, ch_ = 128 * (T_ & 15) + (nd & 127); \
            const int nsrc = T_ < 16 ? (hf_ ? 4096 : 2048) + ch_ : T_ < 32 ? (hf_ ? 12304 + ch_ : ch_) : T_ < 48 ? (hf_ ? 14352 + ch_ : 10240 + ch_) : 6144 + (nd - 12288); \
            ci_.src = P.in[I_WIN] + (size_t)l_ * DM * DIN + (size_t)(kb * 64) * DIN + nsrc; ci_.ldw = DIN; ci_.dst = (bf16*)(ws + WS_WIN) + (size_t)l_ * NPROJ * DM + (size_t)nd * DM + kb * 64; ci_.K = DM; } \
        else if ((r_ -= I_IN) < I_O) { const int kb = r_ >> 5, nb = r_ & 31; ci_.src = P.in[I_WO] + (size_t)l_ * DM * DM + (size_t)(kb * 64) * DM + nb * 64; ci_.ldw = DM; ci_.dst = (bf16*)(ws + WS_WO) + (size_t)l_ * DM * DM + (size_t)(nb * 64) * DM + kb * 64; ci_.K = DM; } \
        else if ((r_ -= I_O) < I_1) { const int kb = r_ >> 7, nb = r_ & 127; ci_.src = P.in[I_W1] + (size_t)l_ * DM * DFF + (size_t)(kb * 64) * DFF + nb * 64; ci_.ldw = DFF; ci_.dst = (bf16*)(ws + WS_W1) + (size_t)l_ * DFF * DM + (size_t)(nb * 64) * DM + kb * 64; ci_.K = DM; } \
        else { r_ -= I_1; const int kb = r_ >> 5, nb = r_ & 31; ci_.src = P.in[I_W2] + (size_t)l_ * DFF * DM + (size_t)(kb * 64) * DM + nb * 64; ci_.ldw = DM; ci_.dst = (bf16*)(ws + WS_W2) + (size_t)l_ * DM * DFF + (size_t)(nb * 64) * DFF + kb * 64; ci_.K = DFF; } } while (0)
    { f32x4 va[16], vb[16], vc[16]; CvtItem ca, cb, cc; int it = gw;
      constexpr int NIT = DEPTH * I_L;
      if (it < NIT) { CVT_DECODE(it, ca); cvt_load(ca, va, lane); }
      if (it + NGW < NIT) { CVT_DECODE(it + NGW, cb); cvt_load(cb, vb, lane); }
      while (it < NIT) {
          if (it + 2 * NGW < NIT) { CVT_DECODE(it + 2 * NGW, cc); cvt_load(cc, vc, lane); }
          cvt_store(ca, va, scr, lane);
          if (it + NGW >= NIT) break;
          if (it + 3 * NGW < NIT) { CVT_DECODE(it + 3 * NGW, ca); cvt_load(ca, va, lane); }
          cvt_store(cb, vb, scr, lane);
          if (it + 2 * NGW >= NIT) break;
          if (it + 4 * NGW < NIT) { CVT_DECODE(it + 4 * NGW, cb); cvt_load(cb, vb, lane); }
          cvt_store(cc, vc, scr, lane);
          it += 3 * NGW; } }
#undef CVT_DECODE
    const int gt = F.vcu * 512 + tid, NGT = F.G * 512;
    for (int i = gt; i < DEPTH * DM * 16; i += NGT) { const int l = i / (DM * 16), r = i % (DM * 16), k = r >> 4, j = r & 15;
        ((bf16*)(ws + WS_WIN))[(size_t)l * NPROJ * DM + (size_t)(W_A1 + j) * DM + k] = f2bf(P.in[I_WIN][(size_t)l * DM * DIN + (size_t)k * DIN + 12288 + j]); }
    constexpr int ZR = NPROJ - (W_A1 + 16);
    for (int i = gt; i < DEPTH * ZR * (DM / 8); i += NGT) { const int l = i / (ZR * (DM / 8)), r = i % (ZR * (DM / 8));
        ((u32x4*)((bf16*)(ws + WS_WIN) + (size_t)l * NPROJ * DM + (size_t)(W_A1 + 16) * DM))[r] = (u32x4){0u, 0u, 0u, 0u}; }
    for (int m = gw; m < MP; m += NGW) {
        float* of = nullptr; bf16* ob = (bf16*)(ws + WS_HB) + (size_t)m * DM;
        if (m >= NTOK) { ((u32x4*)ob)[lane] = (u32x4){0u, 0u, 0u, 0u}; ((u32x4*)ob)[lane + 64] = (u32x4){0u, 0u, 0u, 0u}; ((u32x4*)ob)[lane + 128] = (u32x4){0u, 0u, 0u, 0u}; ((u32x4*)ob)[lane + 192] = (u32x4){0u, 0u, 0u, 0u}; continue; }
        const float* src;
        if (m < NPROMPT) { const int b = m / LP, t = m % LP; src = (t < NMETA) ? P.in[I_META] + (size_t)t * DM : P.in[I_XP] + ((size_t)b * SEQ + (t - NMETA)) * DM; }
        else src = P.in[I_XS] + (size_t)(m - NPROMPT) * DM;
        ln_row(src, P.in[I_LNW], P.in[I_LNB], of, ob, lane);
    }
}

constexpr int PREP_RAWQ = 0, PREP_RAWK = 32768, PREP_RAWV = 65536, PREP_QS = 65536, PREP_KS = 98304, PREP_AS = 0, PREP_A1 = 131072, PREP_TOT = 135168;
__device__ __forceinline__ int prep_swz(int r, int dk) { return r * 512 + ((((dk >> 3) ^ (r & 15)) << 4) | ((dk & 7) << 1)); }
__device__ __forceinline__ void gla_prep_unit(const Frame& F, const Params& P, int l, int ci, int h) {
    unsigned char* ws = P.ws;
    const bf16* proj = (const bf16*)(ws + WS_QKV);
    const int n = ci / NCHUNK, c = ci % NCHUNK;
    const int tok0 = (c == 0) ? 0 : NMETA + 64 * (c - 1), len = (c == 0) ? NMETA : 64, row0 = n * LP + tok0;
    const int u = ci * NH + h;
    bf16* QFb = (bf16*)(ws + WS_QF) + (size_t)u * 16384; bf16* KTFb = (bf16*)(ws + WS_KTF) + (size_t)u * 16384;
    bf16* AFb = (bf16*)(ws + WS_AF) + (size_t)u * 4096; bf16* VTFb = (bf16*)(ws + WS_VTF) + (size_t)u * 32768; float* EBb = (float*)(ws + WS_EB) + (size_t)u * 256;
    const int tid = otid(), lane = tid & 63, d = tid & 255, half = tid >> 8, w = F.wave;
    const __amdgpu_buffer_rsrc_t rsW = __builtin_amdgcn_make_buffer_rsrc((void*)ws, 0, 0x7fffffff, 0x00020000);
#define PREP_ST128(ptr_, val_) __builtin_amdgcn_raw_buffer_store_b128((val_), rsW, (unsigned)((const unsigned char*)(ptr_) - ws), 0, 16)
    LAS float* a1s = (LAS float*)(F.lds + PREP_A1);
    LAS float* tot = (LAS float*)(F.lds + PREP_TOT);
    { const char* gq = (const char*)(proj + (size_t)row0 * QP + C_Q + h * DK) + (lane & 31) * 16; const char* gk = (const char*)(proj + (size_t)row0 * QP + C_K + h * DK) + (lane & 31) * 16;
      const char* gv = (const char*)(proj + (size_t)row0 * QP + C_V + h * DV) + lane * 16;
#pragma unroll
      for (int j = 0; j < 4; ++j) { const int i = w + 8 * j; if (2 * i < len) { const size_t ro = (size_t)(2 * i + (lane >> 5)) * QP * 2;
          __builtin_amdgcn_global_load_lds((const unsigned*)(gq + ro), (LAS unsigned*)(F.lds + PREP_RAWQ + i * 1024), 16, 0, 0);
          __builtin_amdgcn_global_load_lds((const unsigned*)(gk + ro), (LAS unsigned*)(F.lds + PREP_RAWK + i * 1024), 16, 0, 0); } }
#pragma unroll
      for (int j = 0; j < 8; ++j) { const int t = w + 8 * j; if (t < len) __builtin_amdgcn_global_load_lds((const unsigned*)(gv + (size_t)t * QP * 2), (LAS unsigned*)(F.lds + PREP_RAWV + t * 1024), 16, 0, 0); } }
    { const int t = tid >> 3, r2 = tid & 7; unsigned wv = 0u; if (t < len) wv = *(const unsigned*)(proj + (size_t)(row0 + t) * QP + C_A1 + 2 * r2);
      a1s[t * 16 + 2 * r2] = bflo(wv); a1s[t * 16 + 2 * r2 + 1] = bfhi(wv); }
    float wa[16];
#pragma unroll
    for (int r = 0; r < 16; ++r) wa[r] = P.in[I_WA2][(size_t)l * RANK * HK + (size_t)r * HK + h * DK + d];
    const float bz = P.in[I_BA2][(size_t)l * HK + h * DK + d];
    asm volatile("s_waitcnt vmcnt(0) lgkmcnt(0)" ::: "memory"); __syncthreads();
    { const LAS bf16* rv = (const LAS bf16*)(F.lds + PREP_RAWV) + half * 256 + d;
#pragma unroll
      for (int tg = 0; tg < 8; ++tg) { unsigned vv[8];
#pragma unroll
          for (int j = 0; j < 8; ++j) { const int t = 8 * tg + j; const unsigned x = (unsigned)rv[t * 512]; vv[j] = (t < len) ? x : 0u; }
          u32x4 pv; pv.x = vv[0] | (vv[1] << 16); pv.y = vv[2] | (vv[3] << 16); pv.z = vv[4] | (vv[5] << 16); pv.w = vv[6] | (vv[7] << 16);
          PREP_ST128(VTFb + (size_t)((((half * 16 + (d >> 4)) * 2 + (tg >> 2)) * 64 + (d & 15) + 16 * (tg & 3)) * 8), pv); } }
    float bl[32];
    { float b = 0.f;
#pragma unroll
      for (int j = 0; j < 32; ++j) { const int t = 32 * half + j;
          { const LAS f32x4* ar = (const LAS f32x4*)(a1s + t * 16); const f32x4 a0 = ar[0], a1 = ar[1], a2 = ar[2], a3 = ar[3];
              float z = bz; z += a0.x * wa[0] + a0.y * wa[1] + a0.z * wa[2] + a0.w * wa[3]; z += a1.x * wa[4] + a1.y * wa[5] + a1.z * wa[6] + a1.w * wa[7];
              z += a2.x * wa[8] + a2.y * wa[9] + a2.z * wa[10] + a2.w * wa[11]; z += a3.x * wa[12] + a3.y * wa[13] + a3.z * wa[14] + a3.w * wa[15];
              const float ls = logsigmoidf_(z) * (1.0f / 16.0f); b += (t < len) ? ls : 0.f; }
          bl[j] = b; }
      if (half == 0) tot[d] = b; }
    asm volatile("s_waitcnt lgkmcnt(0)" ::: "memory"); __syncthreads();
    { const float off = half ? tot[d] : 0.f;
      const LAS bf16* rq = (const LAS bf16*)(F.lds + PREP_RAWQ) + d; const LAS bf16* rk = (const LAS bf16*)(F.lds + PREP_RAWK) + d;
#pragma unroll
      for (int g = 0; g < 4; ++g) { float kv[8];
#pragma unroll
          for (int j = 0; j < 8; ++j) { const int jj = 8 * g + j, t = 32 * half + jj; float qv = 0.f; kv[j] = 0.f;
              { const float b = bl[jj] + off; const float q0 = bf2f(rq[t * 256]) * __expf(b) * (1.0f / 16.0f), k0 = bf2f(rk[t * 256]) * __expf(-b); qv = (t < len) ? q0 : 0.f; kv[j] = (t < len) ? k0 : 0.f; }
              *(LAS bf16*)(F.lds + PREP_QS + prep_swz(t, d)) = f2bf(qv); }
          u32x4 pk; pk.x = cvt_pk_bf16(kv[0], kv[1]); pk.y = cvt_pk_bf16(kv[2], kv[3]); pk.z = cvt_pk_bf16(kv[4], kv[5]); pk.w = cvt_pk_bf16(kv[6], kv[7]);
#pragma unroll
          for (int j = 0; j < 8; ++j) { const int t = 32 * half + 8 * g + j; const unsigned wv = (j & 1) ? (pk[j >> 1] >> 16) : (pk[j >> 1] & 0xffffu); *(LAS bf16*)(F.lds + PREP_KS + prep_swz(t, d)) = (bf16)wv; }
          const int tg = 4 * half + g;
          PREP_ST128(KTFb + (size_t)((((d >> 4) * 2 + (tg >> 2)) * 64 + (d & 15) + 16 * (tg & 3)) * 8), pk); }
      if (half) __builtin_amdgcn_raw_buffer_store_b32(__builtin_bit_cast(unsigned, __expf(bl[31] + off)), rsW, (unsigned)((const unsigned char*)(EBb + d) - ws), 0, 16); }
    asm volatile("s_waitcnt lgkmcnt(0)" ::: "memory"); __syncthreads();
    const int fr = lane & 15, fq = lane >> 4;
    LAS bf16* As = (LAS bf16*)(F.lds + PREP_AS);
    { const int rt = w >> 1;
#pragma unroll
      for (int i = 0; i < 2; ++i) { const int st = 2 * (w & 1) + i; f32x4 acc = (f32x4){0.f, 0.f, 0.f, 0.f};
          if (st <= rt) {
#pragma unroll
              for (int ks = 0; ks < 8; ++ks) { const bf16x8 a = *(const LAS bf16x8*)(F.lds + PREP_QS + prep_swz(16 * rt + fr, 32 * ks + 8 * fq)); const bf16x8 bb = *(const LAS bf16x8*)(F.lds + PREP_KS + prep_swz(16 * st + fr, 32 * ks + 8 * fq));
                  acc = __builtin_amdgcn_mfma_f32_16x16x32_bf16(a, bb, acc, 0, 0, 0); } }
#pragma unroll
          for (int reg = 0; reg < 4; ++reg) { const int t = 16 * rt + 4 * fq + reg, sx = 16 * st + fr; As[t * 72 + sx] = f2bf(sx <= t ? acc[reg] : 0.f); } } }
    asm volatile("s_waitcnt lgkmcnt(0)" ::: "memory"); __syncthreads();
#pragma unroll
    for (int i = 0; i < 4; ++i) { const int f = 4 * w + i, rt = f >> 3, ks = f & 7, r = 16 * rt + fr;
        const u32x2 lo = *(const LAS u32x2*)(F.lds + PREP_QS + prep_swz(r, 32 * ks + 4 * fq)), hi = *(const LAS u32x2*)(F.lds + PREP_QS + prep_swz(r, 32 * ks + 16 + 4 * fq));
        PREP_ST128(QFb + (size_t)(f * 64 + lane) * 8, ((u32x4){lo.x, lo.y, hi.x, hi.y})); }
    { const int rt = w >> 1, ks = w & 1; const u32x4 av = *(const LAS u32x4*)(As + (16 * rt + fr) * 72 + 32 * ks + 8 * fq); PREP_ST128(AFb + (size_t)(w * 64 + lane) * 8, av); }
#undef PREP_ST128
    asm volatile("s_waitcnt lgkmcnt(0)" ::: "memory"); __syncthreads();
}

constexpr int GLA_BUFB = 66560;
static_assert(PREP_TOT + 1024 <= LDSCTL_OFF && 2 * GLA_BUFB <= LDSCTL_OFF && 8 * 9216 <= LDSCTL_OFF && RING_BYTES <= LDSCTL_OFF, "phase scratch must stay below the LDS control words");
#define GLA_ISSUE(c_, b_) do { const int u_ = ((n * NCHUNK + (c_)) * NH + h); \
        const char* q_ = (const char*)(ws + WS_QF) + (size_t)u_ * 32768 + lane * 16; const char* k_ = (const char*)(ws + WS_KTF) + (size_t)u_ * 32768 + lane * 16; \
        _Pragma("unroll") for (int i_ = 0; i_ < 4; ++i_) { \
            __builtin_amdgcn_global_load_lds((const unsigned*)(q_ + (w + 8 * i_) * 1024), (LAS unsigned*)(F.lds + (b_) * GLA_BUFB + (w + 8 * i_) * 1024), 16, 0, 0); \
            __builtin_amdgcn_global_load_lds((const unsigned*)(k_ + (w + 8 * i_) * 1024), (LAS unsigned*)(F.lds + (b_) * GLA_BUFB + 32768 + (w + 8 * i_) * 1024), 16, 0, 0); } \
        if (w == 0) __builtin_amdgcn_global_load_lds((const unsigned*)((const char*)(ws + WS_EB) + (size_t)u_ * 1024 + lane * 16), (LAS unsigned*)(F.lds + (b_) * GLA_BUFB + 65536), 16, 0, 0); } while (0)
#define GLA_LOADREG(c_, AFd, VFd) do { const int u_ = ((n * NCHUNK + (c_)) * NH + h); \
        const bf16* a_ = (const bf16*)(ws + WS_AF) + (size_t)u_ * 4096 + lane * 8; const bf16* v_ = (const bf16*)(ws + WS_VTF) + (size_t)u_ * 32768 + (size_t)dvt * 1024 + lane * 8; \
        _Pragma("unroll") for (int i_ = 0; i_ < 8; ++i_) AFd[i_] = *(const bf16x8*)(a_ + i_ * 512); \
        VFd[0] = *(const bf16x8*)(v_); VFd[1] = *(const bf16x8*)(v_ + 512); } while (0)
__device__ __forceinline__ void gla_prompt_block(const Frame& F, const Params& P, int l, int item, int lane) {
    unsigned char* ws = P.ws;
    const int w = F.wave, n = item >> 4, h = (item >> 2) & 3, dvt = (item & 3) * 8 + w;
    const int fr = lane & 15, fq = lane >> 4;
    f32x4 S[16];
#pragma unroll
    for (int i = 0; i < 16; ++i) S[i] = (f32x4){0.f, 0.f, 0.f, 0.f};
    const __amdgpu_buffer_rsrc_t rsO = __builtin_amdgcn_make_buffer_rsrc((void*)(ws + WS_OB), 0, 0x7fffffff, 0x00020000);
    unsigned* chk = (unsigned*)(ws + WS_CTL) + CW_CHK + l * CW_CHK_L + ((n * NH + h) * NCHUNK) * 64;
    bf16x8 AFc[8], VFc[2], AFn[8], VFn[2];
    const unsigned* pflag = (const unsigned*)(ws + WS_CTL) + CW_PREP + l * CW_PREP_L + (n * NH + h) * 64 + (lane < NCHUNK ? lane : NCHUNK - 1);
    unsigned* tmo = (unsigned*)(ws + WS_CTL) + CW_TMO;
    int rdy = 0;
#define GLA_WAITPREP(need_) do { if (rdy < (need_)) { unsigned spins_ = 0; \
        for (;;) { const unsigned v_ = __hip_atomic_load(pflag, __ATOMIC_RELAXED, __HIP_MEMORY_SCOPE_AGENT); const unsigned long long m_ = __ballot(v_ != 0u); rdy = (m_ == ~0ull) ? 64 : (int)__builtin_ctzll(~m_); \
            if (rdy >= (need_)) break; __builtin_amdgcn_s_sleep(8); \
            if ((++spins_ & 1023u) == 0u) { if (__hip_atomic_load(tmo, __ATOMIC_RELAXED, __HIP_MEMORY_SCOPE_AGENT) != 0u) break; if (spins_ > (1u << 17)) { __hip_atomic_store(tmo, 1u, __ATOMIC_RELAXED, __HIP_MEMORY_SCOPE_AGENT); break; } } } \
        __builtin_amdgcn_fence(__ATOMIC_ACQUIRE, "agent"); } } while (0)
    GLA_WAITPREP(1);
    GLA_ISSUE(0, 0);
    GLA_LOADREG(0, AFc, VFc);
    asm volatile("" : "+v"(AFc[0]), "+v"(AFc[1]), "+v"(AFc[2]), "+v"(AFc[3]), "+v"(AFc[4]), "+v"(AFc[5]), "+v"(AFc[6]), "+v"(AFc[7]), "+v"(VFc[0]), "+v"(VFc[1]));
#pragma unroll 1
    for (int c = 0; c < NCHUNK; ++c) {
        asm volatile("s_waitcnt vmcnt(0)" ::: "memory");
        __builtin_amdgcn_s_barrier();
        asm volatile("" ::: "memory");
        if (c > 0 && threadIdx.x == 0) __hip_atomic_fetch_add(chk + (c - 1) * 64, 1u, __ATOMIC_RELAXED, __HIP_MEMORY_SCOPE_AGENT);
        if (c + 1 < NCHUNK) { GLA_WAITPREP(c + 2); GLA_ISSUE(c + 1, (c + 1) & 1); GLA_LOADREG(c + 1, AFn, VFn); }
        const LAS unsigned char* B = F.lds + (c & 1) * GLA_BUFB + lane * 16;
        const int tok0 = (c == 0) ? 0 : NMETA + 64 * (c - 1), len = (c == 0) ? NMETA : 64, row0 = n * LP + tok0;
        f32x4 acc[4];
#pragma unroll
        for (int rt = 0; rt < 4; ++rt) acc[rt] = (f32x4){0.f, 0.f, 0.f, 0.f};
        bf16x8 qa[4], qb[4];
#pragma unroll
        for (int rt = 0; rt < 4; ++rt) qa[rt] = *(const LAS bf16x8*)(B + (rt * 8 + 0) * 1024);
#pragma unroll
        for (int ks = 0; ks < 8; ks += 2) {
#pragma unroll
            for (int rt = 0; rt < 4; ++rt) qb[rt] = *(const LAS bf16x8*)(B + (rt * 8 + ks + 1) * 1024);
            { u32x4 p; p.x = cvt_pk_bf16(S[2 * ks][0], S[2 * ks][1]); p.y = cvt_pk_bf16(S[2 * ks][2], S[2 * ks][3]); p.z = cvt_pk_bf16(S[2 * ks + 1][0], S[2 * ks + 1][1]); p.w = cvt_pk_bf16(S[2 * ks + 1][2], S[2 * ks + 1][3]);
              const bf16x8 sfk = __builtin_bit_cast(bf16x8, p);
#pragma unroll
              for (int rt = 0; rt < 4; ++rt) acc[rt] = __builtin_amdgcn_mfma_f32_16x16x32_bf16(sfk, qa[rt], acc[rt], 0, 0, 0); }
            __builtin_amdgcn_sched_group_barrier(0x100, 4, 0); __builtin_amdgcn_sched_group_barrier(0x008, 4, 0);
            if (ks + 2 < 8) {
#pragma unroll
                for (int rt = 0; rt < 4; ++rt) qa[rt] = *(const LAS bf16x8*)(B + (rt * 8 + ks + 2) * 1024); }
            { u32x4 p; p.x = cvt_pk_bf16(S[2 * ks + 2][0], S[2 * ks + 2][1]); p.y = cvt_pk_bf16(S[2 * ks + 2][2], S[2 * ks + 2][3]); p.z = cvt_pk_bf16(S[2 * ks + 3][0], S[2 * ks + 3][1]); p.w = cvt_pk_bf16(S[2 * ks + 3][2], S[2 * ks + 3][3]);
              const bf16x8 sfk = __builtin_bit_cast(bf16x8, p);
#pragma unroll
              for (int rt = 0; rt < 4; ++rt) acc[rt] = __builtin_amdgcn_mfma_f32_16x16x32_bf16(sfk, qb[rt], acc[rt], 0, 0, 0); }
            __builtin_amdgcn_sched_group_barrier(0x100, 4, 0); __builtin_amdgcn_sched_group_barrier(0x008, 4, 0);
        }
#pragma unroll
        for (int rt = 0; rt < 4; ++rt) {
            acc[rt] = __builtin_amdgcn_mfma_f32_16x16x32_bf16(VFc[0], AFc[rt * 2], acc[rt], 0, 0, 0); acc[rt] = __builtin_amdgcn_mfma_f32_16x16x32_bf16(VFc[1], AFc[rt * 2 + 1], acc[rt], 0, 0, 0);
            const int t = 16 * rt + fr; if (t < len) { u32x2 ob; ob.x = (unsigned)f2bf(acc[rt][0]) | ((unsigned)f2bf(acc[rt][1]) << 16); ob.y = (unsigned)f2bf(acc[rt][2]) | ((unsigned)f2bf(acc[rt][3]) << 16);     __builtin_amdgcn_raw_buffer_store_b64(ob, rsO, (unsigned)(((size_t)(row0 + t) * HV + h * DV + dvt * 16 + 4 * fq) * 2), 0, 16  ); }
        }
        const LAS unsigned char* EBl = F.lds + (c & 1) * GLA_BUFB + 65536 + fq * 16;
        bf16x8 ka[8], kb[8]; f32x4 ea[4], eb[4];
#define GLA_KREAD(kd, ed, g_) do { _Pragma("unroll") for (int i_ = 0; i_ < 4; ++i_) { kd[2 * i_] = *(const LAS bf16x8*)(B + 32768 + ((4 * (g_) + i_) * 2) * 1024); kd[2 * i_ + 1] = *(const LAS bf16x8*)(B + 32768 + ((4 * (g_) + i_) * 2 + 1) * 1024); \
            ed[i_] = *(const LAS f32x4*)(EBl + (4 * (g_) + i_) * 64); } } while (0)
#define GLA_KMMA(kd, ed, g_) do { _Pragma("unroll") for (int i_ = 0; i_ < 4; ++i_) { f32x4 s_ = S[4 * (g_) + i_]; s_ = __builtin_amdgcn_mfma_f32_16x16x32_bf16(kd[2 * i_], VFc[0], s_, 0, 0, 0); s_ = __builtin_amdgcn_mfma_f32_16x16x32_bf16(kd[2 * i_ + 1], VFc[1], s_, 0, 0, 0); S[4 * (g_) + i_] = s_ * ed[i_]; } } while (0)
        GLA_KREAD(ka, ea, 0);
        GLA_KREAD(kb, eb, 1); GLA_KMMA(ka, ea, 0); __builtin_amdgcn_sched_group_barrier(0x100, 12, 0); __builtin_amdgcn_sched_group_barrier(0x008, 8, 0);
        GLA_KREAD(ka, ea, 2); GLA_KMMA(kb, eb, 1); __builtin_amdgcn_sched_group_barrier(0x100, 12, 0); __builtin_amdgcn_sched_group_barrier(0x008, 8, 0);
        GLA_KREAD(kb, eb, 3); GLA_KMMA(ka, ea, 2); __builtin_amdgcn_sched_group_barrier(0x100, 12, 0); __builtin_amdgcn_sched_group_barrier(0x008, 8, 0);
        GLA_KMMA(kb, eb, 3);
#undef GLA_KREAD
#undef GLA_KMMA
        __builtin_amdgcn_sched_barrier(0);
        asm volatile("" : "+v"(AFn[0]), "+v"(AFn[1]), "+v"(AFn[2]), "+v"(AFn[3]), "+v"(AFn[4]), "+v"(AFn[5]), "+v"(AFn[6]), "+v"(AFn[7]), "+v"(VFn[0]), "+v"(VFn[1]));
#pragma unroll
        for (int i = 0; i < 8; ++i) AFc[i] = AFn[i];
        VFc[0] = VFn[0]; VFc[1] = VFn[1];
    }
    asm volatile("s_waitcnt vmcnt(0)" ::: "memory"); __builtin_amdgcn_s_barrier(); asm volatile("" ::: "memory");
    if (threadIdx.x == 0) __hip_atomic_fetch_add(chk + (NCHUNK - 1) * 64, 1u, __ATOMIC_RELAXED, __HIP_MEMORY_SCOPE_AGENT);
    float* gp = P.out + O_GP + ((size_t)((l * NB + n) * NH + h) * DK) * DV + dvt * 16 + fr;
#pragma unroll
    for (int dt = 0; dt < 16; ++dt)
#pragma unroll
        for (int reg = 0; reg < 4; ++reg) gp[(size_t)(16 * dt + 4 * fq + reg) * DV] = S[dt][reg];
}

__device__ __forceinline__ void gla_sample_block(const Frame& F, const Params& P, int l, int nh, int tid, int lane) {
    unsigned char* ws = P.ws;
    const bf16* proj = (const bf16*)(ws + WS_QKV);
    const int n = nh >> 2, h = nh & 3, row0 = NPROMPT + DECS * n, w = F.wave;
    LAS float* qs = (LAS float*)F.lds; LAS float* ks = qs + 1024; LAS float* eb = qs + 2048; LAS float* apw = qs + 2304; LAS float* obuf = (LAS float*)(F.lds + 16384);
    if (tid < 256) {
        const int col = h * DK + tid;
        float wv[16]; unsigned qr[4], kr[4]; const float bzv = P.in[I_BA2][(size_t)l * HK + col];
#pragma unroll
        for (int r = 0; r < 16; ++r) wv[r] = P.in[I_WA2][(size_t)l * RANK * HK + (size_t)r * HK + col];
#pragma unroll
        for (int t = 0; t < 4; ++t) { qr[t] = proj[(size_t)(row0 + t) * QP + C_Q + col]; kr[t] = proj[(size_t)(row0 + t) * QP + C_K + col]; }
        float z[4];
#pragma unroll
        for (int t = 0; t < 4; ++t) { z[t] = bzv;
#pragma unroll
            for (int r = 0; r < 8; ++r) { const unsigned a = *(const unsigned*)(proj + (size_t)(row0 + t) * QP + C_A1 + 2 * r); z[t] += bflo(a) * wv[2 * r] + bfhi(a) * wv[2 * r + 1]; } }
        float b = 0.f, qv[4], kv[4];
#pragma unroll
        for (int t = 0; t < 4; ++t) { b += logsigmoidf_(z[t]) * (1.0f / 16.0f); qv[t] = bf2f(qr[t]) * __expf(b) * (1.0f / 16.0f); kv[t] = bf2f(kr[t]) * __expf(-b); qs[t * 256 + tid] = qv[t]; ks[t * 256 + tid] = kv[t]; }
        eb[tid] = __expf(b);
#pragma unroll
        for (int t = 0; t < 4; ++t)
#pragma unroll
            for (int sx = 0; sx < 4; ++sx) if (sx <= t) { const float a = wave_sum(qv[t] * kv[sx]); if (lane == 0) apw[w * 16 + t * 4 + sx] = a; }
    }
    asm volatile("s_waitcnt lgkmcnt(0)" ::: "memory"); __syncthreads();
    f32x4 vv[4][2];
#pragma unroll
    for (int sx = 0; sx < 4; ++sx)
#pragma unroll
        for (int j = 0; j < 2; ++j) { const u32x2 wd = *(const u32x2*)(proj + (size_t)(row0 + sx) * QP + C_V + h * DV + 256 * j + 4 * lane); vv[sx][j] = (f32x4){bflo(wd.x), bfhi(wd.x), bflo(wd.y), bfhi(wd.y)}; }
    f32x4 oacc[4][2];
#pragma unroll
    for (int t = 0; t < 4; ++t) { oacc[t][0] = (f32x4){0.f, 0.f, 0.f, 0.f}; oacc[t][1] = (f32x4){0.f, 0.f, 0.f, 0.f}; }
    const size_t sbase = ((size_t)((l * DECB + n) * NH + h) * DK + 32 * w) * DV + 4 * lane;
    const float* Sin = P.in[I_SGLA] + sbase; float* Sout = P.out + O_GS + sbase;
#pragma unroll 1
    for (int r0 = 0; r0 < 32; r0 += 8) {
        f32x4 s4[8][2];
#pragma unroll
        for (int j = 0; j < 8; ++j) { s4[j][0] = __builtin_nontemporal_load((const f32x4*)(Sin + (size_t)(r0 + j) * DV)); s4[j][1] = __builtin_nontemporal_load((const f32x4*)(Sin + (size_t)(r0 + j) * DV + 256)); }
#pragma unroll
        for (int j = 0; j < 8; ++j) { const int d = 32 * w + r0 + j;
            const float q0 = qs[d], q1 = qs[256 + d], q2 = qs[512 + d], q3 = qs[768 + d], k0 = ks[d], k1 = ks[256 + d], k2 = ks[512 + d], k3 = ks[768 + d], e = eb[d];
#pragma unroll
            for (int c2 = 0; c2 < 2; ++c2) { const f32x4 sv = s4[j][c2];
                oacc[0][c2] += sv * q0; oacc[1][c2] += sv * q1; oacc[2][c2] += sv * q2; oacc[3][c2] += sv * q3;
                const f32x4 kvs = vv[0][c2] * k0 + vv[1][c2] * k1 + vv[2][c2] * k2 + vv[3][c2] * k3;
                __builtin_nontemporal_store((sv + kvs) * e, (f32x4*)(Sout + (size_t)(r0 + j) * DV + 256 * c2)); } }
    }
#pragma unroll
    for (int t = 0; t < 4; ++t)
#pragma unroll
        for (int c2 = 0; c2 < 2; ++c2) *(LAS f32x4*)(obuf + (w * 4 + t) * 512 + 256 * c2 + 4 * lane) = oacc[t][c2];
    asm volatile("s_waitcnt lgkmcnt(0)" ::: "memory"); __syncthreads();
    { const int t = tid >> 7, c = (tid & 127) * 4;
      f32x4 o = (f32x4){0.f, 0.f, 0.f, 0.f};
#pragma unroll
      for (int ww = 0; ww < 8; ++ww) o += *(const LAS f32x4*)(obuf + (ww * 4 + t) * 512 + c);
#pragma unroll
      for (int sx = 0; sx < 4; ++sx) if (sx <= t) { const float a = apw[0 * 16 + t * 4 + sx] + apw[1 * 16 + t * 4 + sx] + apw[2 * 16 + t * 4 + sx] + apw[3 * 16 + t * 4 + sx];
          const u32x2 wd = *(const u32x2*)(proj + (size_t)(row0 + sx) * QP + C_V + h * DV + c); o += (f32x4){bflo(wd.x), bfhi(wd.x), bflo(wd.y), bfhi(wd.y)} * a; }
      u32x2 ob; ob.x = cvt_pk_bf16(o.x, o.y); ob.y = cvt_pk_bf16(o.z, o.w);
      __builtin_amdgcn_raw_buffer_store_b64(ob, __builtin_amdgcn_make_buffer_rsrc((void*)(ws + WS_OB), 0, 0x7fffffff, 0x00020000), (unsigned)(((size_t)(row0 + t) * HV + h * DV + c) * 2), 0, 16  ); }
    asm volatile("s_waitcnt vmcnt(0) lgkmcnt(0)" ::: "memory"); __syncthreads();
    (void)__hip_atomic_fetch_add((unsigned*)(ws + WS_CTL) + CW_SMP + l * CW_SMP_L + (n * NH + h) * 16, tid == 0 ? 4u : 0u, __ATOMIC_RELAXED, __HIP_MEMORY_SCOPE_AGENT);
}

__device__ __forceinline__ void merge_unit(const Params& P, int l, int r0, int nrun, int tpos0, int seqlen, bool prompt, int seq, int h, int lane) {
    unsigned char* ws = P.ws;
    const bf16* PBb = (const bf16*)(ws + WS_PB); const bf16* GCBb = (const bf16*)(ws + WS_GCB); const bf16* GGBb = (const bf16*)(ws + WS_GGB);
    const int c = h * DV + 8 * lane;
    float p1[8], p2[8], w0[8], w1[8], w2[8], gn[8];
    { const float* cw = P.in[I_CONVW] + (size_t)l * 3 * DM + c; const f32x4 a0 = *(const f32x4*)(cw), a1 = *(const f32x4*)(cw + 4), b0 = *(const f32x4*)(cw + DM), b1 = *(const f32x4*)(cw + DM + 4), c0 = *(const f32x4*)(cw + 2 * DM), c1 = *(const f32x4*)(cw + 2 * DM + 4);
      const f32x4 g0 = *(const f32x4*)(P.in[I_GNW] + (size_t)l * DV + 8 * lane), g1 = *(const f32x4*)(P.in[I_GNW] + (size_t)l * DV + 8 * lane + 4);
#pragma unroll
      for (int j = 0; j < 4; ++j) { w0[j] = a0[j]; w0[4 + j] = a1[j]; w1[j] = b0[j]; w1[4 + j] = b1[j]; w2[j] = c0[j]; w2[4 + j] = c1[j]; gn[j] = g0[j]; gn[4 + j] = g1[j]; } }
    if (tpos0 == 0) {
        if (prompt) {
#pragma unroll
            for (int j = 0; j < 8; ++j) { p1[j] = 0.f; p2[j] = 0.f; }
        } else {
            const float* sc = P.in[I_SCONV] + ((size_t)(l * DECB + seq) * 2) * DM + c;
            const f32x4 a0 = *(const f32x4*)(sc), a1 = *(const f32x4*)(sc + 4), b0 = *(const f32x4*)(sc + DM), b1 = *(const f32x4*)(sc + DM + 4);
#pragma unroll
            for (int j = 0; j < 4; ++j) { p2[j] = a0[j]; p2[4 + j] = a1[j]; p1[j] = b0[j]; p1[4 + j] = b1[j]; }
        }
    } else {
        const u32x4 q1 = *(const u32x4*)(PBb + (size_t)(r0 - 1) * DM + c), q2 = *(const u32x4*)(PBb + (size_t)(r0 - 2) * DM + c);
#pragma unroll
        for (int j = 0; j < 4; ++j) { p1[2 * j] = bflo(q1[j]); p1[2 * j + 1] = bfhi(q1[j]); p2[2 * j] = bflo(q2[j]); p2[2 * j + 1] = bfhi(q2[j]); }
    }
    for (int t0 = 0; t0 < nrun; t0 += 4) {
        u32x4 vp[4], vgc[4], vgg[4], vo[4];
#pragma unroll
        for (int i = 0; i < 4; ++i) { const size_t row = (size_t)(r0 + t0 + i);
            vp[i] = *(const u32x4*)(PBb + row * DM + c); vgc[i] = *(const u32x4*)(GCBb + row * DM + c); vgg[i] = *(const u32x4*)(GGBb + row * DM + c);
            vo[i] = *(const u32x4*)((const bf16*)(ws + WS_OB) + row * HV + c); }
#pragma unroll
        for (int i = 0; i < 4; ++i) {
            const int t = t0 + i; const size_t row = (size_t)(r0 + t);
            float ov[8];
#pragma unroll
            for (int j = 0; j < 4; ++j) { ov[2 * j] = bflo(vo[i][j]); ov[2 * j + 1] = bfhi(vo[i][j]); }
            float ss = (ov[0] * ov[0] + ov[1] * ov[1]) + (ov[2] * ov[2] + ov[3] * ov[3]) + (ov[4] * ov[4] + ov[5] * ov[5]) + (ov[6] * ov[6] + ov[7] * ov[7]);
            ss = wave_sum(ss);
            const float rstd = 1.0f / sqrtf(ss * (1.0f / DV) + LN_EPS);
            float m[8], pn[8];
#pragma unroll
            for (int j = 0; j < 8; ++j) {
                const int q = j >> 1; const bool hi = j & 1;
                const float pc = hi ? bfhi(vp[i][q]) : bflo(vp[i][q]), gc = hi ? bfhi(vgc[i][q]) : bflo(vgc[i][q]), gg = hi ? bfhi(vgg[i][q]) : bflo(vgg[i][q]);
                pn[j] = pc;
                const float conv = w0[j] * p2[j] + w1[j] * p1[j] + w2[j] * pc;
                m[j] = gc * conv + (ov[j] * rstd * gn[j]) * gg;
                p2[j] = p1[j]; p1[j] = pc;
            }
            u32x4 mo; mo.x = cvt_pk_bf16(m[0], m[1]); mo.y = cvt_pk_bf16(m[2], m[3]); mo.z = cvt_pk_bf16(m[4], m[5]); mo.w = cvt_pk_bf16(m[6], m[7]);
            *(u32x4*)((bf16*)(ws + WS_MB) + row * DM + c) = mo;
            const int tp = tpos0 + t;
            if (tp >= seqlen - 2) {
                float* cs = prompt ? P.out + O_CP + ((size_t)(l * NB + seq) * 2 + (tp - (seqlen - 2))) * DM + c : P.out + O_CS + ((size_t)(l * DECB + seq) * 2 + (tp - (seqlen - 2))) * DM + c;
                *(f32x4*)(cs) = (f32x4){pn[0], pn[1], pn[2], pn[3]}; *(f32x4*)(cs + 4) = (f32x4){pn[4], pn[5], pn[6], pn[7]};
            }
        }
    }
}

__global__ void __launch_bounds__(512, 2) hybrid_fwd(Params P) {
    extern __shared__ __attribute__((aligned(16))) unsigned char lds_raw[];
    Frame F;
    F.lds = (LAS unsigned char*)lds_raw;
    F.wave = __builtin_amdgcn_readfirstlane((int)threadIdx.x >> 6);
    F.G = gridDim.x; { const int bx = blockIdx.x; F.vcu = (F.G % 8 == 0) ? (bx % 8) * (F.G / 8) + bx / 8 : bx; }
    unsigned char* ws = P.ws;
    for (int u = threadIdx.x; u < (LDS_BYTES - LDSCTL_OFF) / 4; u += 512) ((LAS unsigned*)(F.lds + LDSCTL_OFF))[u] = 0u;
    __syncthreads();
    XcdBarrier bar = xcd_barrier_post((unsigned*)(ws + WS_CTL) + CW_BAR, (volatile LAS unsigned*)(F.lds + MISC_OFF) + 8);
    const int gw = F.vcu * 8 + F.wave, NGW = F.G * 8;
#define GRID_BAR() xcd_barrier(bar)
#define STAMP(k) do { if (STAMP_A >= 0 && threadIdx.x == 0) __hip_atomic_fetch_max((unsigned long long*)((unsigned*)(ws + WS_CTL) + CW_STAMP) + (k), (unsigned long long)__builtin_amdgcn_s_memrealtime(), __ATOMIC_RELAXED, __HIP_MEMORY_SCOPE_AGENT); } while (0)

#if DBG_STAGE < 99
    { const size_t gt = (size_t)blockIdx.x * 512 + otid(), NGT = (size_t)F.G * 512; f32x4* o4 = (f32x4*)P.out; for (size_t i = gt; i < O_END / 4; i += NGT) o4[i] = (f32x4){0.f, 0.f, 0.f, 0.f}; }
    GRID_BAR();
#endif
    REP(0) { p0_prologue(F, P); __syncthreads(); }
    GRID_BAR();

#pragma unroll
    for (int l = 0; l < DEPTH; ++l) {
        if (DBG_STAGE < 99 && l > 0 && DBG_STAGE < 10) break;
        REP(5) { pg8::Gemm g{(const bf16*)(ws + WS_HB), (const bf16*)(ws + WS_WIN) + (size_t)l * NPROJ * DM, MP, NPROJ, DM}; pg8::StaticOrder S; S.init(MP, NPROJ, DM, F.G, (int)blockIdx.x);
          pg8::EpiInProj E{(bf16*)(ws + WS_PB), (bf16*)(ws + WS_GCB), (bf16*)(ws + WS_GGB), (bf16*)(ws + WS_QKV), QP};
          pg8::gemm_phase<pg8::EpiInProj, pg8::StaticOrder, true, true, true>(F.lds, g, S, E); }
        GRID_BAR();
        { const int lane = otid() & 63;
          { const bool chainblk = (F.vcu & 3) == 0 && (F.vcu >> 2) < NB * NH * 4;
            const int wi = F.vcu - (F.vcu >> 2) - 1, NW = F.G - NB * NH * 4;
            unsigned* pf = (unsigned*)(ws + WS_CTL) + CW_PREP + l * CW_PREP_L;
            for (int k = F.vcu; k < NPCH * NH; k = (k < F.G) ? F.G + wi : k + NW) { const int c = k >> 4, nn = (k >> 2) & 3, hh = k & 3;
                gla_prep_unit(F, P, l, nn * NCHUNK + c, hh);
                asm volatile("s_waitcnt vmcnt(0)" ::: "memory"); __syncthreads();
                if (F.wave == 0) (void)__hip_atomic_fetch_add(pf + (nn * NH + hh) * 64 + c, lane == 0 ? 1u : 0u, __ATOMIC_RELAXED, __HIP_MEMORY_SCOPE_AGENT);
                if (chainblk) break; }
            if (chainblk) { gla_prompt_block(F, P, l, F.vcu >> 2, lane); asm volatile("s_waitcnt vmcnt(0) lgkmcnt(0)" ::: "memory"); __syncthreads(); } }
          unsigned* qhead = (unsigned*)(ws + WS_CTL) + CW_QUEUE + 64 * l;
          volatile LAS int* isl = (volatile LAS int*)(F.lds + LDSCTL_OFF + 192);
          for (;;) {
              if (F.wave == 0) { const int v_ = (int)__hip_atomic_fetch_add(qhead, lane == 0 ? 1u : 0u, __ATOMIC_RELAXED, __HIP_MEMORY_SCOPE_AGENT); isl[0] = __builtin_amdgcn_readfirstlane(v_); }
              asm volatile("s_waitcnt vmcnt(0) lgkmcnt(0)" ::: "memory"); __syncthreads();
              const int it = isl[0];
              __syncthreads();
              if (it >= DECB * NH) break;
              gla_sample_block(F, P, l, it, (int)threadIdx.x, lane); }
          asm volatile("s_waitcnt vmcnt(0) lgkmcnt(0)" ::: "memory"); __syncthreads();
          constexpr int MG_CF = 30, MG_NC = 8 * MG_CF, MG_NP = MG_NC + (NCHUNK - MG_CF) * 32, MG_NT = MG_NP + 64;
          unsigned* qhead2 = (unsigned*)(ws + WS_CTL) + CW_QUEUE + 64 * (2 + l);
          volatile LAS int* gsl = (volatile LAS int*)(F.lds + LDSCTL_OFF + 64);
          unsigned* tmo = (unsigned*)(ws + WS_CTL) + CW_TMO;
          for (;;) {
              if (threadIdx.x == 0) { const int g = (int)__hip_atomic_fetch_add(qhead2, 1u, __ATOMIC_RELAXED, __HIP_MEMORY_SCOPE_AGENT);
                  if (g < MG_NT) { unsigned spins = 0; const bool prm = g < MG_NP;
                      int cc, nn; if (g < MG_NC) { cc = g >> 3; nn = (g >> 1) & 3; } else { const int f = g - MG_NC; cc = MG_CF + (f >> 5); nn = (f >> 3) & 3; }
                      for (int k = 0; k < (prm ? 4 : 8); ++k) {
                          const unsigned* cw = prm ? (const unsigned*)(ws + WS_CTL) + CW_CHK + l * CW_CHK_L + ((nn * NH + k) * NCHUNK + cc) * 64
                                                   : (const unsigned*)(ws + WS_CTL) + CW_SMP + l * CW_SMP_L + ((g - MG_NP) * 8 + k) * 16;
                          while (__hip_atomic_load(cw, __ATOMIC_RELAXED, __HIP_MEMORY_SCOPE_AGENT) < 4u) { __builtin_amdgcn_s_sleep(16);
                              if ((++spins & 1023u) == 0u) { if (__hip_atomic_load(tmo, __ATOMIC_RELAXED, __HIP_MEMORY_SCOPE_AGENT) != 0u) break; if (spins > (1u << 17)) { __hip_atomic_store(tmo, 1u, __ATOMIC_RELAXED, __HIP_MEMORY_SCOPE_AGENT); break; } } } }
                      __builtin_amdgcn_fence(__ATOMIC_ACQUIRE, "agent"); asm volatile("s_waitcnt vmcnt(0)" ::: "memory"); }
                  gsl[0] = g; }
              asm volatile("s_waitcnt lgkmcnt(0)" ::: "memory"); __syncthreads();
              const int g = gsl[0];
              __syncthreads();
              if (g >= MG_NT) break;
              { int r0, nrun, tp0, slen, sq, hh; bool pr, act = true;
                if (g < MG_NC) { const int c = g >> 3, n = (g >> 1) & 3, k = F.wave + 8 * (g & 1); pr = true; slen = LP; sq = n; nrun = 16;
                    if (c == 0) { act = k < 4; hh = k & 3; tp0 = 0; } else { hh = k & 3; tp0 = NMETA + 64 * (c - 1) + 16 * (k >> 2); }
                    r0 = n * LP + tp0; }
                else if (g < MG_NP) { const int f = g - MG_NC, c = MG_CF + (f >> 5), n = (f >> 3) & 3, v = (f & 7) * 8 + F.wave; pr = true; slen = LP; sq = n; nrun = 4;
                    hh = v & 3; tp0 = NMETA + 64 * (c - 1) + 4 * (v >> 2); r0 = n * LP + tp0; }
                else { const int v = (g - MG_NP) * 8 + F.wave; hh = v & 3; sq = v >> 2; pr = false; slen = DECS; nrun = DECS; tp0 = 0; r0 = NPROMPT + sq * DECS; }
                if (act) merge_unit(P, l, r0, nrun, tp0, slen, pr, sq, hh, lane); }
          } }
        GRID_BAR();
        if (DBG_STAGE < 3) continue;
        REP(6) { pg8::Gemm g{(const bf16*)(ws + WS_MB), (const bf16*)(ws + WS_WO) + (size_t)l * DM * DM, MP, DM, DM}; pg8::TailSplitOrder S; S.init(MP, DM, DM, F.G, (int)blockIdx.x);
          pg8::EpiResBf16 E{(bf16*)(ws + WS_TF), (const bf16*)(ws + WS_HB), DM, ALPHA, (float*)(ws + WS_PART)};
          pg8::gemm_phase<pg8::EpiResBf16, pg8::TailSplitOrder, true, true>(F.lds, g, S, E); }
        GRID_BAR();
        REP(4) { const int lane = otid() & 63; for (int m = gw; m < NTOK; m += NGW) ln_row_bf((const bf16*)(ws + WS_TF) + (size_t)m * DM, P.in[I_LN1W] + (size_t)l * DM, P.in[I_LN1B] + (size_t)l * DM, nullptr, (bf16*)(ws + WS_HB) + (size_t)m * DM, lane,
                   (F.G == 256 && m >= 8192) ? (const float*)((const bf16*)(ws + WS_PART) + (size_t)((m >> 8) - 32) * 64 * 65536 + (size_t)(m & 255) * 256) : nullptr); }
        GRID_BAR();
        REP(7) { pg8::Gemm g{(const bf16*)(ws + WS_HB), (const bf16*)(ws + WS_W1) + (size_t)l * DFF * DM, MP, DFF, DM}; pg8::StaticOrder S; S.init(MP, DFF, DM, F.G, (int)blockIdx.x);
          pg8::EpiBf16<1> E{(bf16*)(ws + WS_RB), DFF};
          pg8::gemm_phase<pg8::EpiBf16<1>, pg8::StaticOrder, true, true, true>(F.lds, g, S, E); }
        GRID_BAR();
        REP(8) { pg8::Gemm g{(const bf16*)(ws + WS_RB), (const bf16*)(ws + WS_W2) + (size_t)l * DM * DFF, MP, DM, DFF}; pg8::TailSplitOrder S; S.init(MP, DM, DFF, F.G, (int)blockIdx.x);
          pg8::EpiResBf16 E{(bf16*)(ws + WS_TF), (const bf16*)(ws + WS_HB), DM, ALPHA, (float*)(ws + WS_PART)};
          pg8::gemm_phase<pg8::EpiResBf16, pg8::TailSplitOrder, true, true>(F.lds, g, S, E); }
        GRID_BAR();
        { const int lane = otid() & 63;
        for (int m = gw; m < NTOK; m += NGW) {
            const bf16* src = (const bf16*)(ws + WS_TF) + (size_t)m * DM; const float* lw = P.in[I_LN2W] + (size_t)l * DM; const float* lb = P.in[I_LN2B] + (size_t)l * DM;
            const float* part = (F.G == 256 && m >= 8192) ? (const float*)((const bf16*)(ws + WS_PART) + (size_t)((m >> 8) - 32) * 64 * 65536 + (size_t)(m & 255) * 256) : nullptr;
            if (l < DEPTH - 1) ln_row_bf(src, lw, lb, nullptr, (bf16*)(ws + WS_HB) + (size_t)m * DM, lane, part);
            else { float* dst;
                if (m < NPROMPT) { const int b = m / LP, t = m % LP; if (t < NMETA) continue; dst = P.out + O_YP + ((size_t)b * SEQ + (t - NMETA)) * DM; }
                else dst = P.out + O_YS + (size_t)(m - NPROMPT) * DM;
                ln_row_bf(src, lw, lb, dst, nullptr, lane, part); }
        } }
        if (l < DEPTH - 1) GRID_BAR();
    }
#if STAMP_A >= 0
    GRID_BAR();
    { const unsigned long long* ts = (const unsigned long long*)((unsigned*)(ws + WS_CTL) + CW_STAMP);
      const unsigned long long ta = __hip_atomic_load(ts + STAMP_A, __ATOMIC_RELAXED, __HIP_MEMORY_SCOPE_AGENT), tb = __hip_atomic_load(ts + STAMP_B, __ATOMIC_RELAXED, __HIP_MEMORY_SCOPE_AGENT);
      const float Bv = floorf((float)(long long)(tb - ta) * 0.01f * (1.0f / STAMP_Q) + 0.5f) * STAMP_Q;
      for (size_t i = (size_t)blockIdx.x * 512 + threadIdx.x; i < (size_t)NSAMP * DM; i += (size_t)F.G * 512) P.out[O_YS + i] = Bv; }
#endif
}

extern "C" void kernel_launch(void* const* d_in, const int* in_sizes, int n_in, void* d_out, int out_size, void* d_ws, size_t ws_size, hipStream_t stream) {
    static int grid = 0;
    if (grid == 0) {
        if (n_in != 19 || (size_t)out_size != O_END || ws_size < WS_END) { fprintf(stderr, "kernel_launch: unexpected shapes n_in %d out %d ws %zu\n", n_in, out_size, ws_size); grid = -1; return; }
        int dev = 0, cus = 0, per_cu = 0;
        if (hipGetDevice(&dev) != hipSuccess || hipDeviceGetAttribute(&cus, hipDeviceAttributeMultiprocessorCount, dev) != hipSuccess) { grid = -1; return; }
        if (hipFuncSetAttribute((const void*)hybrid_fwd, hipFuncAttributeMaxDynamicSharedMemorySize, LDS_BYTES) != hipSuccess) { fprintf(stderr, "kernel_launch: hipFuncSetAttribute failed\n"); grid = -1; return; }
        if (hipOccupancyMaxActiveBlocksPerMultiprocessor(&per_cu, (const void*)hybrid_fwd, 512, LDS_BYTES) != hipSuccess || per_cu < 1) fprintf(stderr, "kernel_launch: occupancy query says %d\n", per_cu);
        (void)hipGetLastError();
        grid = cus;
    }
    if (grid < 0) return;
    if (hipMemsetAsync((char*)d_ws + WS_CTL, 0, CTL_ZERO_BYTES, stream) != hipSuccess) return;
    Params p{};
    for (int i = 0; i < 19; ++i) p.in[i] = (const float*)d_in[i];
    p.out = (float*)d_out; p.ws = (unsigned char*)d_ws; p.dbg = 0; p.pad = 0;
    hipLaunchKernelGGL(hybrid_fwd, dim3(grid), dim3(512), LDS_BYTES, stream, p);
}
```

```cpp
#include <hip/hip_runtime.h>
#include <cstdio>
#include <cstdint>

#define GAS __attribute__((address_space(1)))
#define LAS __attribute__((address_space(3)))
typedef unsigned short bf16;
typedef short bf16x8 __attribute__((ext_vector_type(8)));
typedef float f32x4 __attribute__((ext_vector_type(4)));
typedef float f32x2 __attribute__((ext_vector_type(2)));
typedef unsigned u32x4 __attribute__((ext_vector_type(4)));
typedef unsigned u32x2 __attribute__((ext_vector_type(2)));

#ifndef DBG_STAGE
#define DBG_STAGE 99
#endif
#ifndef PROBE_REP
#define PROBE_REP 0
#endif
#ifndef STAMP_Q
#define STAMP_Q 16.0f
#endif
#ifndef STAMP_A
#define STAMP_A -1
#endif
#ifndef STAMP_B
#define STAMP_B -1
#endif
#define REP(bit) for (int rep_ = 0; rep_ < 1 + ((PROBE_REP >> (bit)) & 1); ++rep_)

constexpr int DM = 2048, NB = 4, SEQ = 2048, NMETA = 16, LP = SEQ + NMETA, NPROMPT = NB * LP;
constexpr int DECB = 128, DECS = 4, NSAMP = DECB * DECS, NTOK = NPROMPT + NSAMP, MP = 8960;
constexpr int DEPTH = 2, NH = 4, DK = 256, DV = 512, HK = 1024, HV = 2048, RANK = 16, DFF = 8192;
constexpr int DIN = 16400, NPROJ = 16640;
constexpr int W_A1 = 16384;
constexpr int QP = 4352, C_Q = 0, C_K = 1024, C_V = 2048, C_A1 = 4096;
constexpr int NCHUNK = 33, NPCH = NB * NCHUNK;
constexpr float LN_EPS = 1e-5f;
constexpr float ALPHA = 1.41421356237f;
constexpr size_t O_YP = 0, O_YS = 16777216, O_CP = 17825792, O_GP = 17858560, O_CS = 22052864, O_GS = 23101440, O_END = 157319168;

constexpr size_t MiB = 1u << 20;
constexpr size_t WS_CTL = 0, CTL_ZERO_BYTES = 1 * MiB;
constexpr size_t WS_WIN = 1 * MiB, WS_WO = 131 * MiB, WS_W1 = 147 * MiB, WS_W2 = 211 * MiB;
constexpr size_t WS_PB = 450 * MiB, WS_GCB = 485 * MiB, WS_GGB = 520 * MiB, WS_QKV = 555 * MiB;
constexpr size_t WS_HF = 275 * MiB, WS_HB = 345 * MiB, WS_TF = 380 * MiB, WS_PROJ = 450 * MiB, WS_MB = 735 * MiB, WS_RB = 770 * MiB, WS_OB = 910 * MiB;
constexpr size_t WS_QF = 980 * MiB, WS_KTF = 997 * MiB, WS_AF = 1014 * MiB, WS_VTF = 1019 * MiB, WS_EB = 1052 * MiB, WS_PART = 1053 * MiB  , WS_END = 1101 * MiB;
constexpr int CW_BAR = 4096, CW_QUEUE = 8192, CW_STAMP = 12288;
constexpr int CW_TMO = 64;
constexpr int CW_CHK = 16384, CW_CHK_L = 40960;
constexpr int CW_PREP = 131072, CW_PREP_L = 1024;
constexpr int CW_SMP = 98304, CW_SMP_L = 8192;

constexpr int RING_BYTES = 131072, LDSCTL_OFF = 139264  , MISC_OFF = LDSCTL_OFF + 320, LDS_BYTES = 147456;

#define LDS_WAIT() asm volatile("s_waitcnt lgkmcnt(0)" ::: "memory")
#define VM_WAIT() asm volatile("s_waitcnt vmcnt(0)" ::: "memory")
__device__ __forceinline__ unsigned cvt_pk_bf16(float lo, float hi) { unsigned r; asm volatile("v_cvt_pk_bf16_f32 %0, %1, %2" : "=v"(r) : "v"(lo), "v"(hi)); return r; }
__device__ __forceinline__ float bf2f(unsigned u16v) { return __uint_as_float(u16v << 16); }
__device__ __forceinline__ float bflo(unsigned w) { return __uint_as_float(w << 16); }
__device__ __forceinline__ float bfhi(unsigned w) { return __uint_as_float(w & 0xffff0000u); }
__device__ __forceinline__ bf16 f2bf(float f) { unsigned u = __float_as_uint(f); return (bf16)((u + 0x7fffu + ((u >> 16) & 1u)) >> 16); }
__device__ __forceinline__ float wave_sum(float v) {
#pragma unroll
    for (int o = 1; o < 64; o <<= 1) v += __shfl_xor(v, o);
    return v;
}
__device__ __forceinline__ float sigmoidf_(float x) { return 1.0f / (1.0f + __expf(-x)); }
__device__ __forceinline__ float logsigmoidf_(float z) { return fminf(z, 0.f) - __logf(1.0f + __expf(-fabsf(z))); }

namespace pg8 {
#define PG8_LAS __attribute__((address_space(3)))
typedef unsigned short bf16_t;
constexpr int BM = 256, BK = 64, HALF = 128, HTB = HALF * BK * 2, STAGE_BYTES = 8 * HTB, NXCD = 8, WGM = 8;
__host__ __device__ __forceinline__ int lds_byte(int r, int c) { const int st = (r >> 4) * 2 + (c >> 5), rr = r & 15, cc = c & 31, ob = rr * 64 + cc * 2; return st * 1024 + (ob ^ (((ob >> 9) & 1) << 5)); }
__host__ __device__ __forceinline__ void stage_rc(int b, int& R, int& C) { const int st = b / 1024, sb = b % 1024, swz = sb ^ (((sb >> 9) & 1) << 5); R = (st >> 1) * 16 + swz / 64; C = (st & 1) * 32 + (swz % 64) / 2; }
__host__ __device__ __forceinline__ int perm32(int rho) { const int n = rho >> 4, i = rho & 15; return 8 * (i >> 2) + 4 * n + (i & 3); }
struct Unit { int pm, pn, kb, kn, part; };
struct Gemm { const bf16_t* A; const bf16_t* Bt; int M, N, K; };
struct StaticOrder {
    int nM, nN, nwg, G, c, nt;
    __host__ __device__ void init(int M, int N, int K, int G_, int c_) { nM = M / BM; nN = N / BM; nwg = nM * nN; G = G_; c = c_; nt = K / BK; }
    __host__ __device__ bool next(int i, Unit& u) const {
        const long L = (long)i * G + c; if (L >= nwg) return false;
        int wgid = (int)L; { const int q = nwg / NXCD, r = nwg % NXCD, xcd = wgid % NXCD, off = wgid / NXCD; wgid = (xcd < r ? xcd * (q + 1) : r * (q + 1) + (xcd - r) * q) + off; }
        const int nig = WGM * nN, gid = wgid / nig, fm = gid * WGM, gsz = (nM - fm) < WGM ? (nM - fm) : WGM;
        u.pm = fm + ((wgid % nig) % gsz); u.pn = (wgid % nig) / gsz; u.kb = 0; u.kn = nt; u.part = -1; return true;
    }
    __device__ __forceinline__ void a_ready(const Unit&) const {}
    __device__ __forceinline__ void done(const Unit&) const {}
};
struct TailSplitOrder {
    int G, c, nt, nN, nwg;
    __host__ __device__ void init(int M, int N, int K, int G_, int c_) { G = G_; c = c_; nt = K / BK; nN = N / BM; nwg = (M / BM) * nN; }
    __host__ __device__ bool split() const { return G == 256 && nN == 8 && nwg == 280 && (nt % 16) == 0; }
    __host__ __device__ bool next(int i, Unit& u) const {
        if (split()) { const int x = c & 7, j = c >> 3;
            if (i == 0) { u.pm = 4 * x + (j >> 3); u.pn = j & 7; u.kb = 0; u.kn = nt; u.part = -1; return true; }
            if (i == 1 && j < 24) { u.pm = 32 + (j >> 3); u.pn = j & 7; u.kb = x * (nt >> 3); u.kn = nt >> 3; u.part = j * 8 + x; return true; }
            return false; }
        const long L = (long)i * G + c; if (L >= nwg) return false;
        u.pm = (int)(L / nN); u.pn = (int)(L % nN); u.kb = 0; u.kn = nt; u.part = -1; return true;
    }
    __device__ __forceinline__ void a_ready(const Unit&) const {}
    __device__ __forceinline__ void done(const Unit&) const {}
};
template <int ACT  > struct EpiBf16 {
    static constexpr bool PERM = true, AFTER_DRAIN = false;
    bf16_t* O; int ldc;
    __device__ __forceinline__ void operator()(const f32x4 (&acc)[2][2][4][2], const Unit& u, int wr, int wc, int fr, int fq) const {
        const int row0 = u.pm * BM + wr * 64 + fr; const int col0 = u.pn * BM + wc * 32 + 8 * fq;
#pragma unroll
        for (int ai = 0; ai < 2; ++ai)
#pragma unroll
            for (int m = 0; m < 4; ++m) { bf16_t* rowp = O + (size_t)(row0 + ai * HALF + m * 16) * ldc + col0;
#pragma unroll
                for (int bj = 0; bj < 2; ++bj) { f32x4 v0 = acc[ai][bj][m][0], v1 = acc[ai][bj][m][1];
                    if (ACT == 1) {
#pragma unroll
                        for (int j = 0; j < 4; ++j) { const float a = fmaxf(v0[j], 0.f), b = fmaxf(v1[j], 0.f); v0[j] = a * a; v1[j] = b * b; } }
                    u32x4 w; w.x = cvt_pk_bf16(v0[0], v0[1]); w.y = cvt_pk_bf16(v0[2], v0[3]); w.z = cvt_pk_bf16(v1[0], v1[1]); w.w = cvt_pk_bf16(v1[2], v1[3]);
                    *(u32x4*)(rowp + bj * HALF) = w; } }
    }
};
struct EpiInProj {
    static constexpr bool PERM = true, AFTER_DRAIN = false;
    bf16_t* PB; bf16_t* GCB; bf16_t* GGB; bf16_t* QKV; int qp;
    __device__ __forceinline__ static float sig(float x) { return __builtin_amdgcn_rcpf(1.0f + __expf(-x)); }
    __device__ __forceinline__ void operator()(const f32x4 (&acc)[2][2][4][2], const Unit& u, int wr, int wc, int fr, int fq) const {
        const int row0 = u.pm * BM + wr * 64 + fr;
        if (u.pn >= 48) {
            const int col0 = (u.pn - 48) * BM + wc * 32 + 8 * fq;
#pragma unroll
            for (int ai = 0; ai < 2; ++ai)
#pragma unroll
                for (int m = 0; m < 4; ++m) { bf16_t* rowp = QKV + (size_t)(row0 + ai * HALF + m * 16) * qp + col0;
#pragma unroll
                    for (int bj = 0; bj < 2; ++bj) { const f32x4 v0 = acc[ai][bj][m][0], v1 = acc[ai][bj][m][1];
                        u32x4 w; w.x = cvt_pk_bf16(v0[0], v0[1]); w.y = cvt_pk_bf16(v0[2], v0[3]); w.z = cvt_pk_bf16(v1[0], v1[1]); w.w = cvt_pk_bf16(v1[2], v1[3]);
                        *(u32x4*)(rowp + bj * HALF) = w; } }
            return; }
        const int type = u.pn >> 4, col0 = (u.pn & 15) * HALF + wc * 32 + 8 * fq;
#define EIP_TILE(O_, EXPR_) do { _Pragma("unroll") for (int ai = 0; ai < 2; ++ai) _Pragma("unroll") for (int m = 0; m < 4; ++m) { float r[8]; \
            _Pragma("unroll") for (int n = 0; n < 2; ++n) _Pragma("unroll") for (int j = 0; j < 4; ++j) { const float x = acc[ai][0][m][n][j], y = acc[ai][1][m][n][j]; r[4 * n + j] = (EXPR_); } \
            u32x4 w; w.x = cvt_pk_bf16(r[0], r[1]); w.y = cvt_pk_bf16(r[2], r[3]); w.z = cvt_pk_bf16(r[4], r[5]); w.w = cvt_pk_bf16(r[6], r[7]); \
            *(u32x4*)((O_) + (size_t)(row0 + ai * HALF + m * 16) * 2048 + col0) = w; } } while (0)
        if (type == 0) EIP_TILE(PB, x * y);
        else if (type == 1) EIP_TILE(GCB, x * sig(y));
        else EIP_TILE(GGB, x * sig(x) * sig(y));
#undef EIP_TILE
    }
};
struct EpiResBf16 {
    static constexpr bool PERM = true, AFTER_DRAIN = false;
    bf16_t* T; const bf16_t* res; int ldc; float alpha; float* part_buf;
    __device__ __forceinline__ void operator()(const f32x4 (&acc)[2][2][4][2], const Unit& u, int wr, int wc, int fr, int fq) const {
        const int lrow0 = wr * 64 + fr, lcol0 = wc * 32 + 8 * fq;
        const int row0 = u.pm * BM + lrow0, col0 = u.pn * BM + lcol0;
        const bool withres = (u.part < 0) || (u.kb == 0);
        bf16_t* pb = (bf16_t*)part_buf + (size_t)(u.part < 0 ? 0 : u.part) * 65536;
        u32x4 rr[2][4][2];
#pragma unroll
        for (int ai = 0; ai < 2; ++ai)
#pragma unroll
            for (int m = 0; m < 4; ++m)
#pragma unroll
                for (int bj = 0; bj < 2; ++bj) rr[ai][m][bj] = withres ? *(const u32x4*)(res + (size_t)(row0 + ai * HALF + m * 16) * ldc + col0 + bj * HALF) : (u32x4){0u, 0u, 0u, 0u};
        bf16_t* dst = (u.part >= 0) ? pb + lrow0 * 256 + lcol0 : T + (size_t)row0 * ldc + col0;
        const size_t dpitch = (u.part >= 0) ? (size_t)256 : (size_t)ldc;
#pragma unroll
        for (int ai = 0; ai < 2; ++ai)
#pragma unroll
            for (int m = 0; m < 4; ++m)
#pragma unroll
                for (int bj = 0; bj < 2; ++bj) { f32x4 v0 = acc[ai][bj][m][0], v1 = acc[ai][bj][m][1]; const u32x4 r = rr[ai][m][bj];
                    v0 += (f32x4){__uint_as_float(r.x << 16), __uint_as_float(r.x & 0xffff0000u), __uint_as_float(r.y << 16), __uint_as_float(r.y & 0xffff0000u)} * alpha;
                    v1 += (f32x4){__uint_as_float(r.z << 16), __uint_as_float(r.z & 0xffff0000u), __uint_as_float(r.w << 16), __uint_as_float(r.w & 0xffff0000u)} * alpha;
                    u32x4 w; w.x = cvt_pk_bf16(v0[0], v0[1]); w.y = cvt_pk_bf16(v0[2], v0[3]); w.z = cvt_pk_bf16(v1[0], v1[1]); w.w = cvt_pk_bf16(v1[2], v1[3]);
                    *(u32x4*)(dst + (size_t)(ai * HALF + m * 16) * dpitch + bj * HALF) = w; }
    }
};
struct EpiResF32 {
    static constexpr bool PERM = false, AFTER_DRAIN = false;
    float* C; const float* res; int ldc; float alpha; float* part_buf;
    __device__ __forceinline__ void operator()(const f32x4 (&acc)[2][2][4][2], const Unit& u, int wr, int wc, int fr, int fq) const {
        const int lrow0 = wr * 64 + fr, lcol0 = wc * 32 + 4 * fq;
        const int row0 = u.pm * BM + lrow0, col0 = u.pn * BM + lcol0;
        if (u.part >= 0) {
            float* pb = part_buf + (size_t)u.part * 65536; const float a0 = (u.kb == 0) ? alpha : 0.f;
#pragma unroll
            for (int ai = 0; ai < 2; ++ai)
#pragma unroll
                for (int m = 0; m < 4; ++m) { const size_t off = (size_t)(row0 + ai * HALF + m * 16) * ldc + col0; const int loff = (lrow0 + ai * HALF + m * 16) * 256 + lcol0;
#pragma unroll
                    for (int bj = 0; bj < 2; ++bj)
#pragma unroll
                        for (int n = 0; n < 2; ++n) { f32x4 v = acc[ai][bj][m][n]; if (u.kb == 0) { const f32x4 r = *(const f32x4*)(res + off + bj * HALF + n * 16); v = r * a0 + v; } *(f32x4*)(pb + loff + bj * HALF + n * 16) = v; } }
            return; }
#pragma unroll
        for (int ai = 0; ai < 2; ++ai)
#pragma unroll
            for (int m = 0; m < 4; ++m) { const size_t off = (size_t)(row0 + ai * HALF + m * 16) * ldc + col0;
#pragma unroll
                for (int bj = 0; bj < 2; ++bj)
#pragma unroll
                    for (int n = 0; n < 2; ++n) { const f32x4 r = *(const f32x4*)(res + off + bj * HALF + n * 16); *(f32x4*)(C + off + bj * HALF + n * 16) = r * alpha + acc[ai][bj][m][n]; } }
    }
};

template <class Epi, class Sched, bool ALIGN_EPI = false, bool SP2 = false, bool SERP = false>
__device__ __forceinline__ void gemm_phase(PG8_LAS unsigned char* lds, const Gemm g, const Sched& S, const Epi& E) {
    int tid_ = threadIdx.x; asm volatile("" : "+v"(tid_));
    const int tid = tid_, wid = __builtin_amdgcn_readfirstlane(tid >> 6), lane = tid & 63, wr = wid >> 2, wc = wid & 3, fr = lane & 15, fq = lane >> 4;
    const int K = g.K;
    unsigned voffA[2], voffB[2];
#pragma unroll
    for (int i = 0; i < 2; ++i) { int R, C; stage_rc(tid * 16 + i * 8192, R, C); const int Rb = Epi::PERM ? ((R & ~31) + perm32(R & 31)) : R;
        voffA[i] = (unsigned)(R * K + C) * 2u; voffB[i] = (unsigned)(Rb * K + C) * 2u; }
    const size_t kstep = (size_t)(BK * 2);
    const size_t hstep = (size_t)HALF * K * 2;
    const size_t tstep = 2 * hstep;
    const unsigned ldsw = (unsigned)wid * 1024u;
    const int aoff = lds_byte(wr * 64 + fr, fq * 8), boff = lds_byte(wc * 32 + fr, fq * 8);
#define PG8_SA(b, h) (((b) * 2 + (h)) * HTB)
#define PG8_SB(b, h) ((4 + (b) * 2 + (h)) * HTB)
#define PG8_STAGE(bufoff, gbase, voff) do { _Pragma("unroll") for (int _i = 0; _i < 2; ++_i) \
        __builtin_amdgcn_global_load_lds((const unsigned*)((const char*)(gbase) + (voff)[_i]), (PG8_LAS unsigned*)(lds + (bufoff) + ldsw + _i * 8192), 16, 0, 0); } while (0)
#define PG8_LDA(dst, b, h) do { _Pragma("unroll") for (int m = 0; m < 4; ++m) _Pragma("unroll") for (int k = 0; k < 2; ++k) dst[m][k] = *(const PG8_LAS bf16x8*)(lds + PG8_SA(b, h) + aoff + m * 2048 + k * 1024); } while (0)
#define PG8_LDB(dst, b, h) do { _Pragma("unroll") for (int n = 0; n < 2; ++n) _Pragma("unroll") for (int k = 0; k < 2; ++k) dst[n][k] = *(const PG8_LAS bf16x8*)(lds + PG8_SB(b, h) + boff + n * 2048 + k * 1024); } while (0)
#define PG8_MMA(ai, bj, At, Bt) do { __builtin_amdgcn_s_setprio(1); _Pragma("unroll") for (int m = 0; m < 4; ++m) _Pragma("unroll") for (int n = 0; n < 2; ++n) _Pragma("unroll") for (int k = 0; k < 2; ++k) \
        acc[ai][bj][m][n] = __builtin_amdgcn_mfma_f32_16x16x32_bf16(Bt[n][k], At[m][k], acc[ai][bj][m][n], 0, 0, 0); __builtin_amdgcn_s_setprio(0); } while (0)
#define PG8_WAIT_V(n) asm volatile("s_waitcnt vmcnt(" #n ")" ::: "memory")
#define PG8_WAIT_L(n) asm volatile("s_waitcnt lgkmcnt(" #n ")" ::: "memory")
#define PG8_BAR __builtin_amdgcn_s_barrier()
#define PG8_SCHED __builtin_amdgcn_sched_barrier(0)
    Unit cur, nxt; int ui = 0;
    if (!S.next(0, cur)) return;
    f32x4 acc[2][2][4][2];
#pragma unroll
    for (int a = 0; a < 2; ++a)
#pragma unroll
        for (int b = 0; b < 2; ++b)
#pragma unroll
            for (int m = 0; m < 4; ++m)
#pragma unroll
                for (int n = 0; n < 2; ++n) acc[a][b][m][n] = (f32x4){0.f, 0.f, 0.f, 0.f};
    bf16x8 At[4][2], B0[2][2], B1[2][2];
    const char* cA = (const char*)g.A + (size_t)cur.pm * tstep + (size_t)cur.kb * kstep; const char* cB = (const char*)g.Bt + (size_t)cur.pn * tstep + (size_t)cur.kb * kstep;
    S.a_ready(cur);
    if constexpr (SP2) {
        PG8_STAGE(PG8_SB(0, 0), cB, voffB); PG8_STAGE(PG8_SB(0, 1), cB + hstep, voffB); PG8_STAGE(PG8_SA(0, 0), cA, voffA); PG8_STAGE(PG8_SA(0, 1), cA + hstep, voffA);
        if (wr == 1) PG8_BAR;
        PG8_WAIT_V(2); PG8_BAR;
        PG8_STAGE(PG8_SB(1, 0), cB + kstep, voffB); PG8_STAGE(PG8_SA(1, 0), cA + kstep, voffA); PG8_STAGE(PG8_SB(1, 1), cB + hstep + kstep, voffB);
        PG8_WAIT_V(6); PG8_BAR;
    } else {
        PG8_STAGE(PG8_SB(0, 0), cB, voffB); PG8_STAGE(PG8_SA(0, 0), cA, voffA); PG8_STAGE(PG8_SB(0, 1), cB + hstep, voffB); PG8_STAGE(PG8_SA(0, 1), cA + hstep, voffA);
        if (wr == 1) PG8_BAR;
        PG8_WAIT_V(4); PG8_BAR;
        PG8_STAGE(PG8_SB(1, 0), cB + kstep, voffB); PG8_STAGE(PG8_SA(1, 0), cA + kstep, voffA); PG8_STAGE(PG8_SB(1, 1), cB + hstep + kstep, voffB);
        PG8_WAIT_V(6); PG8_BAR;
    }
    for (;;) {
        const bool has_next = S.next(ui + 1, nxt);
        const bool cdn = SERP && (ui & 1), ndn = SERP && !(ui & 1) && has_next;
        const long cst = cdn ? -(long)kstep : (long)kstep, nst = ndn ? -(long)kstep : (long)kstep;
        const size_t nk0 = (size_t)(ndn ? nxt.kb + nxt.kn - 1 : nxt.kb) * kstep;
        const char* nA = has_next ? (const char*)g.A + (size_t)nxt.pm * tstep + nk0 : cA; const char* nB = has_next ? (const char*)g.Bt + (size_t)nxt.pn * tstep + nk0 : cB;
        const int nt = cur.kn;
        for (int t = 0; t < nt; t += 2) {
            const bool last = (t == nt - 2);
            const char* a1 = cA + (long)(t + 1) * cst;
            const char* a2 = last ? nA : cA + (long)(t + 2) * cst; const char* b2 = last ? nB : cB + (long)(t + 2) * cst;
            const long st3 = last ? nst : cst;
            const char* a3 = a2 + st3; const char* b3 = b2 + st3;
            if (last && has_next) S.a_ready(nxt);
            if constexpr (SP2) {
            PG8_LDB(B0, 0, 0); PG8_LDB(B1, 0, 1); PG8_SCHED; PG8_LDA(At, 0, 0); PG8_STAGE(PG8_SA(1, 1), a1 + hstep, voffA);
            PG8_WAIT_V(8); PG8_WAIT_L(0); PG8_BAR; PG8_MMA(0, 0, At, B0); PG8_MMA(0, 1, At, B1); PG8_BAR; PG8_SCHED;
            PG8_LDA(At, 0, 1); PG8_STAGE(PG8_SB(0, 0), b2, voffB); PG8_STAGE(PG8_SB(0, 1), b2 + hstep, voffB); PG8_STAGE(PG8_SA(0, 0), a2, voffA);
            PG8_WAIT_V(8); PG8_WAIT_L(0); PG8_BAR; PG8_MMA(1, 0, At, B0); PG8_MMA(1, 1, At, B1); PG8_BAR; PG8_SCHED;
            PG8_LDB(B0, 1, 0); PG8_LDB(B1, 1, 1); PG8_SCHED; PG8_LDA(At, 1, 0); PG8_STAGE(PG8_SA(0, 1), a2 + hstep, voffA);
            PG8_WAIT_V(8); PG8_WAIT_L(0); PG8_BAR; PG8_MMA(0, 0, At, B0); PG8_MMA(0, 1, At, B1); PG8_BAR; PG8_SCHED;
            PG8_LDA(At, 1, 1); PG8_STAGE(PG8_SB(1, 0), b3, voffB); PG8_STAGE(PG8_SB(1, 1), b3 + hstep, voffB); PG8_STAGE(PG8_SA(1, 0), a3, voffA);
            PG8_WAIT_V(8); PG8_WAIT_L(0); PG8_BAR; PG8_MMA(1, 0, At, B0); PG8_MMA(1, 1, At, B1); PG8_BAR; PG8_SCHED;
            } else {
            PG8_LDB(B0, 0, 0); PG8_SCHED; PG8_LDA(At, 0, 0); PG8_STAGE(PG8_SA(1, 1), a1 + hstep, voffA);
            PG8_WAIT_L(8); PG8_BAR; PG8_WAIT_L(0); PG8_MMA(0, 0, At, B0); PG8_BAR; PG8_SCHED;
            PG8_LDB(B1, 0, 1); PG8_STAGE(PG8_SB(0, 0), b2, voffB);
            PG8_BAR; PG8_WAIT_L(0); PG8_MMA(0, 1, At, B1); PG8_BAR;
            PG8_LDA(At, 0, 1); PG8_STAGE(PG8_SA(0, 0), a2, voffA);
            PG8_BAR; PG8_WAIT_L(0); PG8_MMA(1, 0, At, B0); PG8_BAR; PG8_SCHED;
            PG8_STAGE(PG8_SB(0, 1), b2 + hstep, voffB);
            PG8_WAIT_V(6); PG8_BAR; PG8_MMA(1, 1, At, B1); PG8_BAR;
            PG8_LDB(B0, 1, 0); PG8_SCHED; PG8_LDA(At, 1, 0); PG8_STAGE(PG8_SA(0, 1), a2 + hstep, voffA);
            PG8_WAIT_L(8); PG8_BAR; PG8_WAIT_L(0); PG8_MMA(0, 0, At, B0); PG8_BAR; PG8_SCHED;
            PG8_LDB(B1, 1, 1); PG8_STAGE(PG8_SB(1, 0), b3, voffB);
            PG8_BAR; PG8_WAIT_L(0); PG8_MMA(0, 1, At, B1); PG8_BAR;
            PG8_LDA(At, 1, 1); PG8_STAGE(PG8_SA(1, 0), a3, voffA);
            PG8_BAR; PG8_WAIT_L(0); PG8_MMA(1, 0, At, B0); PG8_BAR; PG8_SCHED;
            PG8_STAGE(PG8_SB(1, 1), b3 + hstep, voffB);
            PG8_WAIT_V(6); PG8_BAR; PG8_MMA(1, 1, At, B1); PG8_BAR;
            }
        }
        if constexpr (ALIGN_EPI) { if (wr == 0) PG8_BAR; }
        if constexpr (!Epi::AFTER_DRAIN) { E(acc, cur, wr, wc, fr, fq); S.done(cur); }
        if (!has_next) break;
#pragma unroll
        for (int a = 0; a < 2; ++a)
#pragma unroll
            for (int b = 0; b < 2; ++b)
#pragma unroll
                for (int m = 0; m < 4; ++m)
#pragma unroll
                    for (int n = 0; n < 2; ++n) acc[a][b][m][n] = (f32x4){0.f, 0.f, 0.f, 0.f};
        cur = nxt; cA = nA; cB = nB; ++ui;
        if constexpr (ALIGN_EPI) { if (wr == 1) PG8_BAR; }
    }
    PG8_WAIT_V(0);
    if constexpr (!ALIGN_EPI) { if (wr == 0) PG8_BAR; }
    PG8_BAR;
#undef PG8_SA
#undef PG8_SB
#undef PG8_STAGE
#undef PG8_LDA
#undef PG8_LDB
#undef PG8_MMA
#undef PG8_WAIT_V
#undef PG8_WAIT_L
#undef PG8_BAR
#undef PG8_SCHED
}
}

#define XB_TMO      128
#define XB_XCNT(j)  (256  + 64 * (j))
#define XB_XSUB(j)  (1280 + 64 * (j))
#define XB_XGEN(j)  (2304 + 64 * (j))
#define XB_TOP      3328
#define XB_TOPGEN   3392
#define XCD_BAR_WORDS 3456
#define XB_SPIN_CAP (1u << 18)
__device__ __forceinline__ unsigned xb_ld(unsigned* p)              { return __hip_atomic_load(p, __ATOMIC_RELAXED, __HIP_MEMORY_SCOPE_AGENT); }
__device__ __forceinline__ unsigned xb_add(unsigned* p, unsigned v) { return __hip_atomic_fetch_add(p, v, __ATOMIC_RELAXED, __HIP_MEMORY_SCOPE_AGENT); }
__device__ __forceinline__ unsigned xb_xcc_id() { return (unsigned)__builtin_amdgcn_s_getreg((3 << 11) | 20) & 0xFu; }
#define XB_SPIN(cond, bar) do { unsigned _sp = 0; while (cond) { __builtin_amdgcn_s_sleep(1); \
    if ((++_sp & 255u) == 0u) { if (xb_ld(&(bar)[XB_TMO])) break; if (_sp > XB_SPIN_CAP) { atomicAdd(&(bar)[XB_TMO], 1u); break; } } } } while (0)
struct XcdBarrier { unsigned* bar; unsigned x; volatile LAS unsigned* st; };
__device__ __forceinline__ XcdBarrier xcd_barrier_post(unsigned* bar, volatile LAS unsigned* st) {
    XcdBarrier b; b.bar = bar; b.x = xb_xcc_id(); b.st = st;
    if (threadIdx.x == 0) (void)xb_add(&bar[XB_XCNT(b.x)], 1u);
    return b;
}
__device__ __forceinline__ void xcd_barrier_complete(unsigned* bar, unsigned x, unsigned& nloc, unsigned& nx) {
    const unsigned G = gridDim.x * gridDim.y * gridDim.z;
    unsigned sum, cnt, mine, sp = 0u;
    for (;;) {
        sum = 0u; cnt = 0u; mine = 0u;
#pragma unroll
        for (unsigned j = 0; j < 16; ++j) { const unsigned c = xb_ld(&bar[XB_XCNT(j)]); sum += c; cnt += (c > 0u) ? 1u : 0u; mine = (j == x) ? c : mine; }
        if (sum == G) break;
        __builtin_amdgcn_s_sleep(1);
        if ((++sp & 255u) == 0u) { if (xb_ld(&bar[XB_TMO])) break; if (sp > XB_SPIN_CAP) { atomicAdd(&bar[XB_TMO], 1u); break; } }
    }
    nloc = mine > 0u ? mine : 1u; nx = cnt > 0u ? cnt : 1u;
}
__device__ __forceinline__ void xcd_barrier(const XcdBarrier& b) {
    asm volatile("s_waitcnt vmcnt(0)" ::: "memory");
    __syncthreads();
    if (threadIdx.x == 0) {
        unsigned* bar = b.bar;
        unsigned bx = b.x; asm volatile("" : "+s"(bx));
        __builtin_amdgcn_s_waitcnt(0);
        unsigned nloc = b.st[0], nx = b.st[1];
        if (nloc == 0u) { xcd_barrier_complete(bar, bx, nloc, nx); b.st[0] = nloc; b.st[1] = nx; }
        const unsigned old = xb_add(&bar[XB_XSUB(bx)], 1u);
        const unsigned gen = old / nloc;
        if (old + 1u == (gen + 1u) * nloc) {
            __builtin_amdgcn_fence(__ATOMIC_RELEASE, "agent");
            asm volatile("s_waitcnt vmcnt(0)" ::: "memory");
            const unsigned og = xb_add(&bar[XB_TOP], 1u);
            const unsigned tg = og / nx;
            if (og + 1u == (tg + 1u) * nx) xb_add(&bar[XB_TOPGEN], 1u);
            else XB_SPIN(xb_ld(&bar[XB_TOPGEN]) == tg, bar);
            __builtin_amdgcn_fence(__ATOMIC_ACQUIRE, "agent");
            xb_add(&bar[XB_XGEN(bx)], 1u);
            asm volatile("s_waitcnt vmcnt(0)" ::: "memory");
        } else {
            XB_SPIN(xb_ld(&bar[XB_XGEN(bx)]) == gen, bar);
            __builtin_amdgcn_fence(__ATOMIC_ACQUIRE, "agent");
            asm volatile("s_waitcnt vmcnt(0)" ::: "memory");
        }
    }
    __syncthreads();
}

struct Params { const float* in[19]; float* out; unsigned char* ws; int dbg; int pad; };
enum { I_XP = 0, I_XS, I_SCONV, I_SGLA, I_META, I_LNW, I_LNB, I_WIN, I_CONVW, I_WA2, I_BA2, I_GNW, I_WO, I_LN1W, I_LN1B, I_W1, I_W2, I_LN2W, I_LN2B };

struct Frame {
    LAS unsigned char* lds;
    int wave, vcu, G;
};
__device__ __forceinline__ int otid() { int t = threadIdx.x; asm volatile("" : "+v"(t)); return t; }

struct CvtItem { const float* src; bf16* dst; int ldw, K; };
__device__ __forceinline__ void cvt_load(const CvtItem& ci, f32x4 (&v)[16], int lane) {
    const int r = lane >> 4, c4 = lane & 15;
#pragma unroll
    for (int i = 0; i < 16; ++i) v[i] = *(const f32x4*)(ci.src + (size_t)(4 * i + r) * ci.ldw + 4 * c4);
}
__device__ __forceinline__ void cvt_store(const CvtItem& ci, const f32x4 (&v)[16], LAS float* scr, int lane) {
    const int r = lane >> 4, c4 = lane & 15;
#pragma unroll
    for (int i = 0; i < 16; ++i) { const int k = 4 * i + r; *(LAS f32x4*)(scr + k * 64 + ((4 * c4) ^ (((k >> 3) & 7) << 2))) = v[i]; }
    LDS_WAIT();
    const int c = lane & 7, nn = lane >> 3;
#pragma unroll
    for (int p = 0; p < 8; ++p) { const int n = 8 * p + nn; const LAS float* s = scr + (8 * c) * 64 + (n ^ (c << 2));
        u32x4 o; o.x = cvt_pk_bf16(s[0], s[64]); o.y = cvt_pk_bf16(s[128], s[192]); o.z = cvt_pk_bf16(s[256], s[320]); o.w = cvt_pk_bf16(s[384], s[448]);
        *(u32x4*)(ci.dst + (size_t)n * ci.K + 8 * c) = o; }
    LDS_WAIT();
}
__device__ __forceinline__ void ln_row(const float* xrow, const float* w, const float* b, float* of, bf16* ob, int lane, const float* part = nullptr) {
    (void)part;
    const f32x4* xr = (const f32x4*)xrow + lane;
    f32x4 wv[8], bv[8];
#pragma unroll
    for (int j = 0; j < 8; ++j) { wv[j] = ((const f32x4*)w)[lane + 64 * j]; bv[j] = ((const f32x4*)b)[lane + 64 * j]; }
    f32x4 v[8]; float s = 0.f;
#pragma unroll
    for (int j = 0; j < 8; ++j) v[j] = xr[64 * j];
#pragma unroll
    for (int j = 0; j < 8; ++j) s += (v[j].x + v[j].y) + (v[j].z + v[j].w);
    const float mean = wave_sum(s) * (1.f / DM); float s2 = 0.f;
#pragma unroll
    for (int j = 0; j < 8; ++j) { v[j] = v[j] - mean; s2 += (v[j].x * v[j].x + v[j].y * v[j].y) + (v[j].z * v[j].z + v[j].w * v[j].w); }
    const float rstd = 1.f / sqrtf(wave_sum(s2) * (1.f / DM) + LN_EPS);
#pragma unroll
    for (int j = 0; j < 8; ++j) { const f32x4 y = v[j] * rstd * wv[j] + bv[j];
        if (of) ((f32x4*)of)[lane + 64 * j] = y;
        if (ob) { u32x2 o; o.x = cvt_pk_bf16(y.x, y.y); o.y = cvt_pk_bf16(y.z, y.w); ((u32x2*)ob)[lane + 64 * j] = o; } }
}

__device__ __forceinline__ void ln_row_bf(const bf16* xrow, const float* w, const float* b, float* of, bf16* ob, int lane, const float* part) {
    f32x4 wv[4][2], bv[4][2];
#pragma unroll
    for (int j = 0; j < 4; ++j) { const int c = 8 * lane + 512 * j; wv[j][0] = *(const f32x4*)(w + c); wv[j][1] = *(const f32x4*)(w + c + 4); bv[j][0] = *(const f32x4*)(b + c); bv[j][1] = *(const f32x4*)(b + c + 4); }
    f32x4 v[4][2]; float s = 0.f;
    if (part) {
#pragma unroll
        for (int j = 0; j < 4; ++j) { const int c = 8 * lane + 512 * j; const bf16* pp = (const bf16*)part + (size_t)((c >> 8) * 8) * 65536 + (c & 255);
            u32x4 r[8];
#pragma unroll
            for (int x = 0; x < 8; ++x) r[x] = *(const u32x4*)(pp + (size_t)x * 65536);
            f32x4 a0 = (f32x4){0.f, 0.f, 0.f, 0.f}, a1 = a0;
#pragma unroll
            for (int x = 0; x < 8; ++x) { a0 += (f32x4){bflo(r[x].x), bfhi(r[x].x), bflo(r[x].y), bfhi(r[x].y)}; a1 += (f32x4){bflo(r[x].z), bfhi(r[x].z), bflo(r[x].w), bfhi(r[x].w)}; }
            v[j][0] = a0; v[j][1] = a1; }
    } else {
        u32x4 r[4];
#pragma unroll
        for (int j = 0; j < 4; ++j) r[j] = *(const u32x4*)(xrow + 8 * lane + 512 * j);
#pragma unroll
        for (int j = 0; j < 4; ++j) { v[j][0] = (f32x4){bflo(r[j].x), bfhi(r[j].x), bflo(r[j].y), bfhi(r[j].y)}; v[j][1] = (f32x4){bflo(r[j].z), bfhi(r[j].z), bflo(r[j].w), bfhi(r[j].w)}; }
    }
#pragma unroll
    for (int j = 0; j < 4; ++j) s += ((v[j][0].x + v[j][0].y) + (v[j][0].z + v[j][0].w)) + ((v[j][1].x + v[j][1].y) + (v[j][1].z + v[j][1].w));
    const float mean = wave_sum(s) * (1.f / DM); float s2 = 0.f;
#pragma unroll
    for (int j = 0; j < 4; ++j)
#pragma unroll
        for (int k = 0; k < 2; ++k) { v[j][k] = v[j][k] - mean; s2 += (v[j][k].x * v[j][k].x + v[j][k].y * v[j][k].y) + (v[j][k].z * v[j][k].z + v[j][k].w * v[j][k].w); }
    const float rstd = 1.f / sqrtf(wave_sum(s2) * (1.f / DM) + LN_EPS);
#pragma unroll
    for (int j = 0; j < 4; ++j) { const int c = 8 * lane + 512 * j;
        const f32x4 y0 = v[j][0] * rstd * wv[j][0] + bv[j][0], y1 = v[j][1] * rstd * wv[j][1] + bv[j][1];
        if (of) { *(f32x4*)(of + c) = y0; *(f32x4*)(of + c + 4) = y1; }
        if (ob) { u32x4 o; o.x = cvt_pk_bf16(y0.x, y0.y); o.y = cvt_pk_bf16(y0.z, y0.w); o.z = cvt_pk_bf16(y1.x, y1.y); o.w = cvt_pk_bf16(y1.z, y1.w); *(u32x4*)(ob + c) = o; } }
}
__device__ __forceinline__ void p0_prologue(const Frame& F, const Params& P) {
    unsigned char* ws = P.ws;
    const int tid = otid(), lane = tid & 63;
    LAS float* scr = (LAS float*)(F.lds + F.wave * 16384);
    const int gw = F.vcu * 8 + F.wave, NGW = F.G * 8;
    constexpr int I_IN = 32 * 256, I_O = 32 * 32, I_1 = 32 * 128, I_2 = 128 * 32, I_L = I_IN + I_O + I_1 + I_2;
#define CVT_DECODE(it_, ci_) do { const int l_ = (it_) / I_L; int r_ = (it_) % I_L; \
        if (r_ < I_IN) { const int kb = r_ >> 8, nb = r_ & 255; const int nd = nb * 64, T_ = nd >> 8, hf_ = (nd >> 7) & 1, ch_ = 128 * (T_ & 15) + (nd & 127); \
            const int nsrc = T_ < 16 ? (hf_ ? 4096 : 2048) + ch_ : T_ < 32 ? (hf_ ? 12304 + ch_ : ch_) : T_ < 48 ? (hf_ ? 14352 + ch_ : 10240 + ch_) : 6144 + (nd - 12288); \
            ci_.src = P.in[I_WIN] + (size_t)l_ * DM * DIN + (size_t)(kb * 64) * DIN + nsrc; ci_.ldw = DIN; ci_.dst = (bf16*)(ws + WS_WIN) + (size_t)l_ * NPROJ * DM + (size_t)nd * DM + kb * 64; ci_.K = DM; } \
        else if ((r_ -= I_IN) < I_O) { const int kb = r_ >> 5, nb = r_ & 31; ci_.src = P.in[I_WO] + (size_t)l_ * DM * DM + (size_t)(kb * 64) * DM + nb * 64; ci_.ldw = DM; ci_.dst = (bf16*)(ws + WS_WO) + (size_t)l_ * DM * DM + (size_t)(nb * 64) * DM + kb * 64; ci_.K = DM; } \
        else if ((r_ -= I_O) < I_1) { const int kb = r_ >> 7, nb = r_ & 127; ci_.src = P.in[I_W1] + (size_t)l_ * DM * DFF + (size_t)(kb * 64) * DFF + nb * 64; ci_.ldw = DFF; ci_.dst = (bf16*)(ws + WS_W1) + (size_t)l_ * DFF * DM + (size_t)(nb * 64) * DM + kb * 64; ci_.K = DM; } \
        else { r_ -= I_1; const int kb = r_ >> 5, nb = r_ & 31; ci_.src = P.in[I_W2] + (size_t)l_ * DFF * DM + (size_t)(kb * 64) * DM + nb * 64; ci_.ldw = DM; ci_.dst = (bf16*)(ws + WS_W2) + (size_t)l_ * DM * DFF + (size_t)(nb * 64) * DFF + kb * 64; ci_.K = DFF; } } while (0)
    { f32x4 va[16], vb[16], vc[16]; CvtItem ca, cb, cc; int it = gw;
      constexpr int NIT = DEPTH * I_L;
      if (it < NIT) { CVT_DECODE(it, ca); cvt_load(ca, va, lane); }
      if (it + NGW < NIT) { CVT_DECODE(it + NGW, cb); cvt_load(cb, vb, lane); }
      while (it < NIT) {
          if (it + 2 * NGW < NIT) { CVT_DECODE(it + 2 * NGW, cc); cvt_load(cc, vc, lane); }
          cvt_store(ca, va, scr, lane);
          if (it + NGW >= NIT) break;
          if (it + 3 * NGW < NIT) { CVT_DECODE(it + 3 * NGW, ca); cvt_load(ca, va, lane); }
          cvt_store(cb, vb, scr, lane);
          if (it + 2 * NGW >= NIT) break;
          if (it + 4 * NGW < NIT) { CVT_DECODE(it + 4 * NGW, cb); cvt_load(cb, vb, lane); }
          cvt_store(cc, vc, scr, lane);
          it += 3 * NGW; } }
#undef CVT_DECODE
    const int gt = F.vcu * 512 + tid, NGT = F.G * 512;
    for (int i = gt; i < DEPTH * DM * 16; i += NGT) { const int l = i / (DM * 16), r = i % (DM * 16), k = r >> 4, j = r & 15;
        ((bf16*)(ws + WS_WIN))[(size_t)l * NPROJ * DM + (size_t)(W_A1 + j) * DM + k] = f2bf(P.in[I_WIN][(size_t)l * DM * DIN + (size_t)k * DIN + 12288 + j]); }
    constexpr int ZR = NPROJ - (W_A1 + 16);
    for (int i = gt; i < DEPTH * ZR * (DM / 8); i += NGT) { const int l = i / (ZR * (DM / 8)), r = i % (ZR * (DM / 8));
        ((u32x4*)((bf16*)(ws + WS_WIN) + (size_t)l * NPROJ * DM + (size_t)(W_A1 + 16) * DM))[r] = (u32x4){0u, 0u, 0u, 0u}; }
    for (int m = gw; m < MP; m += NGW) {
        float* of = nullptr; bf16* ob = (bf16*)(ws + WS_HB) + (size_t)m * DM;
        if (m >= NTOK) { ((u32x4*)ob)[lane] = (u32x4){0u, 0u, 0u, 0u}; ((u32x4*)ob)[lane + 64] = (u32x4){0u, 0u, 0u, 0u}; ((u32x4*)ob)[lane + 128] = (u32x4){0u, 0u, 0u, 0u}; ((u32x4*)ob)[lane + 192] = (u32x4){0u, 0u, 0u, 0u}; continue; }
        const float* src;
        if (m < NPROMPT) { const int b = m / LP, t = m % LP; src = (t < NMETA) ? P.in[I_META] + (size_t)t * DM : P.in[I_XP] + ((size_t)b * SEQ + (t - NMETA)) * DM; }
        else src = P.in[I_XS] + (size_t)(m - NPROMPT) * DM;
        ln_row(src, P.in[I_LNW], P.in[I_LNB], of, ob, lane);
    }
}

constexpr int PREP_RAWQ = 0, PREP_RAWK = 32768, PREP_RAWV = 65536, PREP_QS = 65536, PREP_KS = 98304, PREP_AS = 0, PREP_A1 = 131072, PREP_TOT = 135168;
__device__ __forceinline__ int prep_swz(int r, int dk) { return r * 512 + ((((dk >> 3) ^ (r & 15)) << 4) | ((dk & 7) << 1)); }
__device__ __forceinline__ void gla_prep_unit(const Frame& F, const Params& P, int l, int ci, int h) {
    unsigned char* ws = P.ws;
    const bf16* proj = (const bf16*)(ws + WS_QKV);
    const int n = ci / NCHUNK, c = ci % NCHUNK;
    const int tok0 = (c == 0) ? 0 : NMETA + 64 * (c - 1), len = (c == 0) ? NMETA : 64, row0 = n * LP + tok0;
    const int u = ci * NH + h;
    bf16* QFb = (bf16*)(ws + WS_QF) + (size_t)u * 16384; bf16* KTFb = (bf16*)(ws + WS_KTF) + (size_t)u * 16384;
    bf16* AFb = (bf16*)(ws + WS_AF) + (size_t)u * 4096; bf16* VTFb = (bf16*)(ws + WS_VTF) + (size_t)u * 32768; float* EBb = (float*)(ws + WS_EB) + (size_t)u * 256;
    const int tid = otid(), lane = tid & 63, d = tid & 255, half = tid >> 8, w = F.wave;
    const __amdgpu_buffer_rsrc_t rsW = __builtin_amdgcn_make_buffer_rsrc((void*)ws, 0, 0x7fffffff, 0x00020000);
#define PREP_ST128(ptr_, val_) __builtin_amdgcn_raw_buffer_store_b128((val_), rsW, (unsigned)((const unsigned char*)(ptr_) - ws), 0, 16)
    LAS float* a1s = (LAS float*)(F.lds + PREP_A1);
    LAS float* tot = (LAS float*)(F.lds + PREP_TOT);
    { const char* gq = (const char*)(proj + (size_t)row0 * QP + C_Q + h * DK) + (lane & 31) * 16; const char* gk = (const char*)(proj + (size_t)row0 * QP + C_K + h * DK) + (lane & 31) * 16;
      const char* gv = (const char*)(proj + (size_t)row0 * QP + C_V + h * DV) + lane * 16;
#pragma unroll
      for (int j = 0; j < 4; ++j) { const int i = w + 8 * j; if (2 * i < len) { const size_t ro = (size_t)(2 * i + (lane >> 5)) * QP * 2;
          __builtin_amdgcn_global_load_lds((const unsigned*)(gq + ro), (LAS unsigned*)(F.lds + PREP_RAWQ + i * 1024), 16, 0, 0);
          __builtin_amdgcn_global_load_lds((const unsigned*)(gk + ro), (LAS unsigned*)(F.lds + PREP_RAWK + i * 1024), 16, 0, 0); } }
#pragma unroll
      for (int j = 0; j < 8; ++j) { const int t = w + 8 * j; if (t < len) __builtin_amdgcn_global_load_lds((const unsigned*)(gv + (size_t)t * QP * 2), (LAS unsigned*)(F.lds + PREP_RAWV + t * 1024), 16, 0, 0); } }
    { const int t = tid >> 3, r2 = tid & 7; unsigned wv = 0u; if (t < len) wv = *(const unsigned*)(proj + (size_t)(row0 + t) * QP + C_A1 + 2 * r2);
      a1s[t * 16 + 2 * r2] = bflo(wv); a1s[t * 16 + 2 * r2 + 1] = bfhi(wv); }
    float wa[16];
#pragma unroll
    for (int r = 0; r < 16; ++r) wa[r] = P.in[I_WA2][(size_t)l * RANK * HK + (size_t)r * HK + h * DK + d];
    const float bz = P.in[I_BA2][(size_t)l * HK + h * DK + d];
    asm volatile("s_waitcnt vmcnt(0) lgkmcnt(0)" ::: "memory"); __syncthreads();
    { const LAS bf16* rv = (const LAS bf16*)(F.lds + PREP_RAWV) + half * 256 + d;
#pragma unroll
      for (int tg = 0; tg < 8; ++tg) { unsigned vv[8];
#pragma unroll
          for (int j = 0; j < 8; ++j) { const int t = 8 * tg + j; const unsigned x = (unsigned)rv[t * 512]; vv[j] = (t < len) ? x : 0u; }
          u32x4 pv; pv.x = vv[0] | (vv[1] << 16); pv.y = vv[2] | (vv[3] << 16); pv.z = vv[4] | (vv[5] << 16); pv.w = vv[6] | (vv[7] << 16);
          PREP_ST128(VTFb + (size_t)((((half * 16 + (d >> 4)) * 2 + (tg >> 2)) * 64 + (d & 15) + 16 * (tg & 3)) * 8), pv); } }
    float bl[32];
    { float b = 0.f;
#pragma unroll
      for (int j = 0; j < 32; ++j) { const int t = 32 * half + j;
          { const LAS f32x4* ar = (const LAS f32x4*)(a1s + t * 16); const f32x4 a0 = ar[0], a1 = ar[1], a2 = ar[2], a3 = ar[3];
              float z = bz; z += a0.x * wa[0] + a0.y * wa[1] + a0.z * wa[2] + a0.w * wa[3]; z += a1.x * wa[4] + a1.y * wa[5] + a1.z * wa[6] + a1.w * wa[7];
              z += a2.x * wa[8] + a2.y * wa[9] + a2.z * wa[10] + a2.w * wa[11]; z += a3.x * wa[12] + a3.y * wa[13] + a3.z * wa[14] + a3.w * wa[15];
              const float ls = logsigmoidf_(z) * (1.0f / 16.0f); b += (t < len) ? ls : 0.f; }
          bl[j] = b; }
      if (half == 0) tot[d] = b; }
    asm volatile("s_waitcnt lgkmcnt(0)" ::: "memory"); __syncthreads();
    { const float off = half ? tot[d] : 0.f;
      const LAS bf16* rq = (const LAS bf16*)(F.lds + PREP_RAWQ) + d; const LAS bf16* rk = (const LAS bf16*)(F.lds + PREP_RAWK) + d;
#pragma unroll
      for (int g = 0; g < 4; ++g) { float kv[8];
#pragma unroll
          for (int j = 0; j < 8; ++j) { const int jj = 8 * g + j, t = 32 * half + jj; float qv = 0.f; kv[j] = 0.f;
              { const float b = bl[jj] + off; const float q0 = bf2f(rq[t * 256]) * __expf(b) * (1.0f / 16.0f), k0 = bf2f(rk[t * 256]) * __expf(-b); qv = (t < len) ? q0 : 0.f; kv[j] = (t < len) ? k0 : 0.f; }
              *(LAS bf16*)(F.lds + PREP_QS + prep_swz(t, d)) = f2bf(qv); }
          u32x4 pk; pk.x = cvt_pk_bf16(kv[0], kv[1]); pk.y = cvt_pk_bf16(kv[2], kv[3]); pk.z = cvt_pk_bf16(kv[4], kv[5]); pk.w = cvt_pk_bf16(kv[6], kv[7]);
#pragma unroll
          for (int j = 0; j < 8; ++j) { const int t = 32 * half + 8 * g + j; const unsigned wv = (j & 1) ? (pk[j >> 1] >> 16) : (pk[j >> 1] & 0xffffu); *(LAS bf16*)(F.lds + PREP_KS + prep_swz(t, d)) = (bf16)wv; }
          const int tg = 4 * half + g;
          PREP_ST128(KTFb + (size_t)((((d >> 4) * 2 + (tg >> 2)) * 64 + (d & 15) + 16 * (tg & 3)) * 8), pk); }
      if (half) __builtin_amdgcn_raw_buffer_store_b32(__builtin_bit_cast(unsigned, __expf(bl[31] + off)), rsW, (unsigned)((const unsigned char*)(EBb + d) - ws), 0, 16); }
    asm volatile("s_waitcnt lgkmcnt(0)" ::: "memory"); __syncthreads();
    const int fr = lane & 15, fq = lane >> 4;
    LAS bf16* As = (LAS bf16*)(F.lds + PREP_AS);
    { const int rt = w >> 1;
#pragma unroll
      for (int i = 0; i < 2; ++i) { const int st = 2 * (w & 1) + i; f32x4 acc = (f32x4){0.f, 0.f, 0.f, 0.f};
          if (st <= rt) {
#pragma unroll
              for (int ks = 0; ks < 8; ++ks) { const bf16x8 a = *(const LAS bf16x8*)(F.lds + PREP_QS + prep_swz(16 * rt + fr, 32 * ks + 8 * fq)); const bf16x8 bb = *(const LAS bf16x8*)(F.lds + PREP_KS + prep_swz(16 * st + fr, 32 * ks + 8 * fq));
                  acc = __builtin_amdgcn_mfma_f32_16x16x32_bf16(a, bb, acc, 0, 0, 0); } }
#pragma unroll
          for (int reg = 0; reg < 4; ++reg) { const int t = 16 * rt + 4 * fq + reg, sx = 16 * st + fr; As[t * 72 + sx] = f2bf(sx <= t ? acc[reg] : 0.f); } } }
    asm volatile("s_waitcnt lgkmcnt(0)" ::: "memory"); __syncthreads();
#pragma unroll
    for (int i = 0; i < 4; ++i) { const int f = 4 * w + i, rt = f >> 3, ks = f & 7, r = 16 * rt + fr;
        const u32x2 lo = *(const LAS u32x2*)(F.lds + PREP_QS + prep_swz(r, 32 * ks + 4 * fq)), hi = *(const LAS u32x2*)(F.lds + PREP_QS + prep_swz(r, 32 * ks + 16 + 4 * fq));
        PREP_ST128(QFb + (size_t)(f * 64 + lane) * 8, ((u32x4){lo.x, lo.y, hi.x, hi.y})); }
    { const int rt = w >> 1, ks = w & 1; const u32x4 av = *(const LAS u32x4*)(As + (16 * rt + fr) * 72 + 32 * ks + 8 * fq); PREP_ST128(AFb + (size_t)(w * 64 + lane) * 8, av); }
#undef PREP_ST128
    asm volatile("s_waitcnt lgkmcnt(0)" ::: "memory"); __syncthreads();
}

constexpr int GLA_BUFB = 66560;
static_assert(PREP_TOT + 1024 <= LDSCTL_OFF && 2 * GLA_BUFB <= LDSCTL_OFF && 8 * 9216 <= LDSCTL_OFF && RING_BYTES <= LDSCTL_OFF, "phase scratch must stay below the LDS control words");
#define GLA_ISSUE(c_, b_) do { const int u_ = ((n * NCHUNK + (c_)) * NH + h); \
        const char* q_ = (const char*)(ws + WS_QF) + (size_t)u_ * 32768 + lane * 16; const char* k_ = (const char*)(ws + WS_KTF) + (size_t)u_ * 32768 + lane * 16; \
        _Pragma("unroll") for (int i_ = 0; i_ < 4; ++i_) { \
            __builtin_amdgcn_global_load_lds((const unsigned*)(q_ + (w + 8 * i_) * 1024), (LAS unsigned*)(F.lds + (b_) * GLA_BUFB + (w + 8 * i_) * 1024), 16, 0, 0); \
            __builtin_amdgcn_global_load_lds((const unsigned*)(k_ + (w + 8 * i_) * 1024), (LAS unsigned*)(F.lds + (b_) * GLA_BUFB + 32768 + (w + 8 * i_) * 1024), 16, 0, 0); } \
        if (w == 0) __builtin_amdgcn_global_load_lds((const unsigned*)((const char*)(ws + WS_EB) + (size_t)u_ * 1024 + lane * 16), (LAS unsigned*)(F.lds + (b_) * GLA_BUFB + 65536), 16, 0, 0); } while (0)
#define GLA_LOADREG(c_, AFd, VFd) do { const int u_ = ((n * NCHUNK + (c_)) * NH + h); \
        const bf16* a_ = (const bf16*)(ws + WS_AF) + (size_t)u_ * 4096 + lane * 8; const bf16* v_ = (const bf16*)(ws + WS_VTF) + (size_t)u_ * 32768 + (size_t)dvt * 1024 + lane * 8; \
        _Pragma("unroll") for (int i_ = 0; i_ < 8; ++i_) AFd[i_] = *(const bf16x8*)(a_ + i_ * 512); \
        VFd[0] = *(const bf16x8*)(v_); VFd[1] = *(const bf16x8*)(v_ + 512); } while (0)
__device__ __forceinline__ void gla_prompt_block(const Frame& F, const Params& P, int l, int item, int lane) {
    unsigned char* ws = P.ws;
    const int w = F.wave, n = item >> 4, h = (item >> 2) & 3, dvt = (item & 3) * 8 + w;
    const int fr = lane & 15, fq = lane >> 4;
    f32x4 S[16];
#pragma unroll
    for (int i = 0; i < 16; ++i) S[i] = (f32x4){0.f, 0.f, 0.f, 0.f};
    const __amdgpu_buffer_rsrc_t rsO = __builtin_amdgcn_make_buffer_rsrc((void*)(ws + WS_OB), 0, 0x7fffffff, 0x00020000);
    unsigned* chk = (unsigned*)(ws + WS_CTL) + CW_CHK + l * CW_CHK_L + ((n * NH + h) * NCHUNK) * 64;
    bf16x8 AFc[8], VFc[2], AFn[8], VFn[2];
    const unsigned* pflag = (const unsigned*)(ws + WS_CTL) + CW_PREP + l * CW_PREP_L + (n * NH + h) * 64 + (lane < NCHUNK ? lane : NCHUNK - 1);
    unsigned* tmo = (unsigned*)(ws + WS_CTL) + CW_TMO;
    int rdy = 0;
#define GLA_WAITPREP(need_) do { if (rdy < (need_)) { unsigned spins_ = 0; \
        for (;;) { const unsigned v_ = __hip_atomic_load(pflag, __ATOMIC_RELAXED, __HIP_MEMORY_SCOPE_AGENT); const unsigned long long m_ = __ballot(v_ != 0u); rdy = (m_ == ~0ull) ? 64 : (int)__builtin_ctzll(~m_); \
            if (rdy >= (need_)) break; __builtin_amdgcn_s_sleep(8); \
            if ((++spins_ & 1023u) == 0u) { if (__hip_atomic_load(tmo, __ATOMIC_RELAXED, __HIP_MEMORY_SCOPE_AGENT) != 0u) break; if (spins_ > (1u << 17)) { __hip_atomic_store(tmo, 1u, __ATOMIC_RELAXED, __HIP_MEMORY_SCOPE_AGENT); break; } } } \
        __builtin_amdgcn_fence(__ATOMIC_ACQUIRE, "agent"); } } while (0)
    GLA_WAITPREP(1);
    GLA_ISSUE(0, 0);
    GLA_LOADREG(0, AFc, VFc);
    asm volatile("" : "+v"(AFc[0]), "+v"(AFc[1]), "+v"(AFc[2]), "+v"(AFc[3]), "+v"(AFc[4]), "+v"(AFc[5]), "+v"(AFc[6]), "+v"(AFc[7]), "+v"(VFc[0]), "+v"(VFc[1]));
#pragma unroll 1
    for (int c = 0; c < NCHUNK; ++c) {
        asm volatile("s_waitcnt vmcnt(0)" ::: "memory");
        __builtin_amdgcn_s_barrier();
        asm volatile("" ::: "memory");
        if (c > 0 && threadIdx.x == 0) __hip_atomic_fetch_add(chk + (c - 1) * 64, 1u, __ATOMIC_RELAXED, __HIP_MEMORY_SCOPE_AGENT);
        if (c + 1 < NCHUNK) { GLA_WAITPREP(c + 2); GLA_ISSUE(c + 1, (c + 1) & 1); GLA_LOADREG(c + 1, AFn, VFn); }
        const LAS unsigned char* B = F.lds + (c & 1) * GLA_BUFB + lane * 16;
        const int tok0 = (c == 0) ? 0 : NMETA + 64 * (c - 1), len = (c == 0) ? NMETA : 64, row0 = n * LP + tok0;
        f32x4 acc[4];
#pragma unroll
        for (int rt = 0; rt < 4; ++rt) acc[rt] = (f32x4){0.f, 0.f, 0.f, 0.f};
        bf16x8 qa[4], qb[4];
#pragma unroll
        for (int rt = 0; rt < 4; ++rt) qa[rt] = *(const LAS bf16x8*)(B + (rt * 8 + 0) * 1024);
#pragma unroll
        for (int ks = 0; ks < 8; ks += 2) {
#pragma unroll
            for (int rt = 0; rt < 4; ++rt) qb[rt] = *(const LAS bf16x8*)(B + (rt * 8 + ks + 1) * 1024);
            { u32x4 p; p.x = cvt_pk_bf16(S[2 * ks][0], S[2 * ks][1]); p.y = cvt_pk_bf16(S[2 * ks][2], S[2 * ks][3]); p.z = cvt_pk_bf16(S[2 * ks + 1][0], S[2 * ks + 1][1]); p.w = cvt_pk_bf16(S[2 * ks + 1][2], S[2 * ks + 1][3]);
              const bf16x8 sfk = __builtin_bit_cast(bf16x8, p);
#pragma unroll
              for (int rt = 0; rt < 4; ++rt) acc[rt] = __builtin_amdgcn_mfma_f32_16x16x32_bf16(sfk, qa[rt], acc[rt], 0, 0, 0); }
            __builtin_amdgcn_sched_group_barrier(0x100, 4, 0); __builtin_amdgcn_sched_group_barrier(0x008, 4, 0);
            if (ks + 2 < 8) {
#pragma unroll
                for (int rt = 0; rt < 4; ++rt) qa[rt] = *(const LAS bf16x8*)(B + (rt * 8 + ks + 2) * 1024); }
            { u32x4 p; p.x = cvt_pk_bf16(S[2 * ks + 2][0], S[2 * ks + 2][1]); p.y = cvt_pk_bf16(S[2 * ks + 2][2], S[2 * ks + 2][3]); p.z = cvt_pk_bf16(S[2 * ks + 3][0], S[2 * ks + 3][1]); p.w = cvt_pk_bf16(S[2 * ks + 3][2], S[2 * ks + 3][3]);
              const bf16x8 sfk = __builtin_bit_cast(bf16x8, p);
#pragma unroll
              for (int rt = 0; rt < 4; ++rt) acc[rt] = __builtin_amdgcn_mfma_f32_16x16x32_bf16(sfk, qb[rt], acc[rt], 0, 0, 0); }
            __builtin_amdgcn_sched_group_barrier(0x100, 4, 0); __builtin_amdgcn_sched_group_barrier(0x008, 4, 0);
        }
#pragma unroll
        for (int rt = 0; rt < 4; ++rt) {
            acc[rt] = __builtin_amdgcn_mfma_f32_16x16x32_bf16(VFc[0], AFc[rt * 2], acc[rt], 0, 0, 0); acc[rt] = __builtin_amdgcn_mfma_f32_16x16x32_bf16(VFc[1], AFc[rt * 2 + 1], acc[rt], 0, 0, 0);
            const int t = 16 * rt + fr; if (t < len) { u32x2 ob; ob.x = (unsigned)f2bf(acc[rt][0]) | ((unsigned)f2bf(acc[rt][1]) << 16); ob.y = (unsigned)f2bf(acc[rt][2]) | ((unsigned)f2bf(acc[rt][3]) << 16);     __builtin_amdgcn_raw_buffer_store_b64(ob, rsO, (unsigned)(((size_t)(row0 + t) * HV + h * DV + dvt * 16 + 4 * fq) * 2), 0, 16  ); }
        }
        const LAS unsigned char* EBl = F.lds + (c & 1) * GLA_BUFB + 65536 + fq * 16;
        bf16x8 ka[8], kb[8]; f32x4 ea[4], eb[4];
#define GLA_KREAD(kd, ed, g_) do { _Pragma("unroll") for (int i_ = 0; i_ < 4; ++i_) { kd[2 * i_] = *(const LAS bf16x8*)(B + 32768 + ((4 * (g_) + i_) * 2) * 1024); kd[2 * i_ + 1] = *(const LAS bf16x8*)(B + 32768 + ((4 * (g_) + i_) * 2 + 1) * 1024); \
            ed[i_] = *(const LAS f32x4*)(EBl + (4 * (g_) + i_) * 64); } } while (0)
#define GLA_KMMA(kd, ed, g_) do { _Pragma("unroll") for (int i_ = 0; i_ < 4; ++i_) { f32x4 s_ = S[4 * (g_) + i_]; s_ = __builtin_amdgcn_mfma_f32_16x16x32_bf16(kd[2 * i_], VFc[0], s_, 0, 0, 0); s_ = __builtin_amdgcn_mfma_f32_16x16x32_bf16(kd[2 * i_ + 1], VFc[1], s_, 0, 0, 0); S[4 * (g_) + i_] = s_ * ed[i_]; } } while (0)
        GLA_KREAD(ka, ea, 0);
        GLA_KREAD(kb, eb, 1); GLA_KMMA(ka, ea, 0); __builtin_amdgcn_sched_group_barrier(0x100, 12, 0); __builtin_amdgcn_sched_group_barrier(0x008, 8, 0);
        GLA_KREAD(ka, ea, 2); GLA_KMMA(kb, eb, 1); __builtin_amdgcn_sched_group_barrier(0x100, 12, 0); __builtin_amdgcn_sched_group_barrier(0x008, 8, 0);
        GLA_KREAD(kb, eb, 3); GLA_KMMA(ka, ea, 2); __builtin_amdgcn_sched_group_barrier(0x100, 12, 0); __builtin_amdgcn_sched_group_barrier(0x008, 8, 0);
        GLA_KMMA(kb, eb, 3);
#undef GLA_KREAD
#undef GLA_KMMA
        __builtin_amdgcn_sched_barrier(0);
        asm volatile("" : "+v"(AFn[0]), "+v"(AFn[1]), "+v"(AFn[2]), "+v"(AFn[3]), "+v"(AFn[4]), "+v"(AFn[5]), "+v"(AFn[6]), "+v"(AFn[7]), "+v"(VFn[0]), "+v"(VFn[1]));
#pragma unroll
        for (int i = 0; i < 8; ++i) AFc[i] = AFn[i];
        VFc[0] = VFn[0]; VFc[1] = VFn[1];
    }
    asm volatile("s_waitcnt vmcnt(0)" ::: "memory"); __builtin_amdgcn_s_barrier(); asm volatile("" ::: "memory");
    if (threadIdx.x == 0) __hip_atomic_fetch_add(chk + (NCHUNK - 1) * 64, 1u, __ATOMIC_RELAXED, __HIP_MEMORY_SCOPE_AGENT);
    float* gp = P.out + O_GP + ((size_t)((l * NB + n) * NH + h) * DK) * DV + dvt * 16 + fr;
#pragma unroll
    for (int dt = 0; dt < 16; ++dt)
#pragma unroll
        for (int reg = 0; reg < 4; ++reg) gp[(size_t)(16 * dt + 4 * fq + reg) * DV] = S[dt][reg];
}

__device__ __forceinline__ void gla_sample_block(const Frame& F, const Params& P, int l, int nh, int tid, int lane) {
    unsigned char* ws = P.ws;
    const bf16* proj = (const bf16*)(ws + WS_QKV);
    const int n = nh >> 2, h = nh & 3, row0 = NPROMPT + DECS * n, w = F.wave;
    LAS float* qs = (LAS float*)F.lds; LAS float* ks = qs + 1024; LAS float* eb = qs + 2048; LAS float* apw = qs + 2304; LAS float* obuf = (LAS float*)(F.lds + 16384);
    if (tid < 256) {
        const int col = h * DK + tid;
        float wv[16]; unsigned qr[4], kr[4]; const float bzv = P.in[I_BA2][(size_t)l * HK + col];
#pragma unroll
        for (int r = 0; r < 16; ++r) wv[r] = P.in[I_WA2][(size_t)l * RANK * HK + (size_t)r * HK + col];
#pragma unroll
        for (int t = 0; t < 4; ++t) { qr[t] = proj[(size_t)(row0 + t) * QP + C_Q + col]; kr[t] = proj[(size_t)(row0 + t) * QP + C_K + col]; }
        float z[4];
#pragma unroll
        for (int t = 0; t < 4; ++t) { z[t] = bzv;
#pragma unroll
            for (int r = 0; r < 8; ++r) { const unsigned a = *(const unsigned*)(proj + (size_t)(row0 + t) * QP + C_A1 + 2 * r); z[t] += bflo(a) * wv[2 * r] + bfhi(a) * wv[2 * r + 1]; } }
        float b = 0.f, qv[4], kv[4];
#pragma unroll
        for (int t = 0; t < 4; ++t) { b += logsigmoidf_(z[t]) * (1.0f / 16.0f); qv[t] = bf2f(qr[t]) * __expf(b) * (1.0f / 16.0f); kv[t] = bf2f(kr[t]) * __expf(-b); qs[t * 256 + tid] = qv[t]; ks[t * 256 + tid] = kv[t]; }
        eb[tid] = __expf(b);
#pragma unroll
        for (int t = 0; t < 4; ++t)
#pragma unroll
            for (int sx = 0; sx < 4; ++sx) if (sx <= t) { const float a = wave_sum(qv[t] * kv[sx]); if (lane == 0) apw[w * 16 + t * 4 + sx] = a; }
    }
    asm volatile("s_waitcnt lgkmcnt(0)" ::: "memory"); __syncthreads();
    f32x4 vv[4][2];
#pragma unroll
    for (int sx = 0; sx < 4; ++sx)
#pragma unroll
        for (int j = 0; j < 2; ++j) { const u32x2 wd = *(const u32x2*)(proj + (size_t)(row0 + sx) * QP + C_V + h * DV + 256 * j + 4 * lane); vv[sx][j] = (f32x4){bflo(wd.x), bfhi(wd.x), bflo(wd.y), bfhi(wd.y)}; }
    f32x4 oacc[4][2];
#pragma unroll
    for (int t = 0; t < 4; ++t) { oacc[t][0] = (f32x4){0.f, 0.f, 0.f, 0.f}; oacc[t][1] = (f32x4){0.f, 0.f, 0.f, 0.f}; }
    const size_t sbase = ((size_t)((l * DECB + n) * NH + h) * DK + 32 * w) * DV + 4 * lane;
    const float* Sin = P.in[I_SGLA] + sbase; float* Sout = P.out + O_GS + sbase;
#pragma unroll 1
    for (int r0 = 0; r0 < 32; r0 += 8) {
        f32x4 s4[8][2];
#pragma unroll
        for (int j = 0; j < 8; ++j) { s4[j][0] = __builtin_nontemporal_load((const f32x4*)(Sin + (size_t)(r0 + j) * DV)); s4[j][1] = __builtin_nontemporal_load((const f32x4*)(Sin + (size_t)(r0 + j) * DV + 256)); }
#pragma unroll
        for (int j = 0; j < 8; ++j) { const int d = 32 * w + r0 + j;
            const float q0 = qs[d], q1 = qs[256 + d], q2 = qs[512 + d], q3 = qs[768 + d], k0 = ks[d], k1 = ks[256 + d], k2 = ks[512 + d], k3 = ks[768 + d], e = eb[d];
#pragma unroll
            for (int c2 = 0; c2 < 2; ++c2) { const f32x4 sv = s4[j][c2];
                oacc[0][c2] += sv * q0; oacc[1][c2] += sv * q1; oacc[2][c2] += sv * q2; oacc[3][c2] += sv * q3;
                const f32x4 kvs = vv[0][c2] * k0 + vv[1][c2] * k1 + vv[2][c2] * k2 + vv[3][c2] * k3;
                __builtin_nontemporal_store((sv + kvs) * e, (f32x4*)(Sout + (size_t)(r0 + j) * DV + 256 * c2)); } }
    }
#pragma unroll
    for (int t = 0; t < 4; ++t)
#pragma unroll
        for (int c2 = 0; c2 < 2; ++c2) *(LAS f32x4*)(obuf + (w * 4 + t) * 512 + 256 * c2 + 4 * lane) = oacc[t][c2];
    asm volatile("s_waitcnt lgkmcnt(0)" ::: "memory"); __syncthreads();
    { const int t = tid >> 7, c = (tid & 127) * 4;
      f32x4 o = (f32x4){0.f, 0.f, 0.f, 0.f};
#pragma unroll
      for (int ww = 0; ww < 8; ++ww) o += *(const LAS f32x4*)(obuf + (ww * 4 + t) * 512 + c);
#pragma unroll
      for (int sx = 0; sx < 4; ++sx) if (sx <= t) { const float a = apw[0 * 16 + t * 4 + sx] + apw[1 * 16 + t * 4 + sx] + apw[2 * 16 + t * 4 + sx] + apw[3 * 16 + t * 4 + sx];
          const u32x2 wd = *(const u32x2*)(proj + (size_t)(row0 + sx) * QP + C_V + h * DV + c); o += (f32x4){bflo(wd.x), bfhi(wd.x), bflo(wd.y), bfhi(wd.y)} * a; }
      u32x2 ob; ob.x = cvt_pk_bf16(o.x, o.y); ob.y = cvt_pk_bf16(o.z, o.w);
      __builtin_amdgcn_raw_buffer_store_b64(ob, __builtin_amdgcn_make_buffer_rsrc((void*)(ws + WS_OB), 0, 0x7fffffff, 0x00020000), (unsigned)(((size_t)(row0 + t) * HV + h * DV + c) * 2), 0, 16  ); }
    asm volatile("s_waitcnt vmcnt(0) lgkmcnt(0)" ::: "memory"); __syncthreads();
    (void)__hip_atomic_fetch_add((unsigned*)(ws + WS_CTL) + CW_SMP + l * CW_SMP_L + (n * NH + h) * 16, tid == 0 ? 4u : 0u, __ATOMIC_RELAXED, __HIP_MEMORY_SCOPE_AGENT);
}

__device__ __forceinline__ void merge_unit(const Params& P, int l, int r0, int nrun, int tpos0, int seqlen, bool prompt, int seq, int h, int lane) {
    unsigned char* ws = P.ws;
    const bf16* PBb = (const bf16*)(ws + WS_PB); const bf16* GCBb = (const bf16*)(ws + WS_GCB); const bf16* GGBb = (const bf16*)(ws + WS_GGB);
    const int c = h * DV + 8 * lane;
    float p1[8], p2[8], w0[8], w1[8], w2[8], gn[8];
    { const float* cw = P.in[I_CONVW] + (size_t)l * 3 * DM + c; const f32x4 a0 = *(const f32x4*)(cw), a1 = *(const f32x4*)(cw + 4), b0 = *(const f32x4*)(cw + DM), b1 = *(const f32x4*)(cw + DM + 4), c0 = *(const f32x4*)(cw + 2 * DM), c1 = *(const f32x4*)(cw + 2 * DM + 4);
      const f32x4 g0 = *(const f32x4*)(P.in[I_GNW] + (size_t)l * DV + 8 * lane), g1 = *(const f32x4*)(P.in[I_GNW] + (size_t)l * DV + 8 * lane + 4);
#pragma unroll
      for (int j = 0; j < 4; ++j) { w0[j] = a0[j]; w0[4 + j] = a1[j]; w1[j] = b0[j]; w1[4 + j] = b1[j]; w2[j] = c0[j]; w2[4 + j] = c1[j]; gn[j] = g0[j]; gn[4 + j] = g1[j]; } }
    if (tpos0 == 0) {
        if (prompt) {
#pragma unroll
            for (int j = 0; j < 8; ++j) { p1[j] = 0.f; p2[j] = 0.f; }
        } else {
            const float* sc = P.in[I_SCONV] + ((size_t)(l * DECB + seq) * 2) * DM + c;
            const f32x4 a0 = *(const f32x4*)(sc), a1 = *(const f32x4*)(sc + 4), b0 = *(const f32x4*)(sc + DM), b1 = *(const f32x4*)(sc + DM + 4);
#pragma unroll
            for (int j = 0; j < 4; ++j) { p2[j] = a0[j]; p2[4 + j] = a1[j]; p1[j] = b0[j]; p1[4 + j] = b1[j]; }
        }
    } else {
        const u32x4 q1 = *(const u32x4*)(PBb + (size_t)(r0 - 1) * DM + c), q2 = *(const u32x4*)(PBb + (size_t)(r0 - 2) * DM + c);
#pragma unroll
        for (int j = 0; j < 4; ++j) { p1[2 * j] = bflo(q1[j]); p1[2 * j + 1] = bfhi(q1[j]); p2[2 * j] = bflo(q2[j]); p2[2 * j + 1] = bfhi(q2[j]); }
    }
    for (int t0 = 0; t0 < nrun; t0 += 4) {
        u32x4 vp[4], vgc[4], vgg[4], vo[4];
#pragma unroll
        for (int i = 0; i < 4; ++i) { const size_t row = (size_t)(r0 + t0 + i);
            vp[i] = *(const u32x4*)(PBb + row * DM + c); vgc[i] = *(const u32x4*)(GCBb + row * DM + c); vgg[i] = *(const u32x4*)(GGBb + row * DM + c);
            vo[i] = *(const u32x4*)((const bf16*)(ws + WS_OB) + row * HV + c); }
#pragma unroll
        for (int i = 0; i < 4; ++i) {
            const int t = t0 + i; const size_t row = (size_t)(r0 + t);
            float ov[8];
#pragma unroll
            for (int j = 0; j < 4; ++j) { ov[2 * j] = bflo(vo[i][j]); ov[2 * j + 1] = bfhi(vo[i][j]); }
            float ss = (ov[0] * ov[0] + ov[1] * ov[1]) + (ov[2] * ov[2] + ov[3] * ov[3]) + (ov[4] * ov[4] + ov[5] * ov[5]) + (ov[6] * ov[6] + ov[7] * ov[7]);
            ss = wave_sum(ss);
            const float rstd = 1.0f / sqrtf(ss * (1.0f / DV) + LN_EPS);
            float m[8], pn[8];
#pragma unroll
            for (int j = 0; j < 8; ++j) {
                const int q = j >> 1; const bool hi = j & 1;
                const float pc = hi ? bfhi(vp[i][q]) : bflo(vp[i][q]), gc = hi ? bfhi(vgc[i][q]) : bflo(vgc[i][q]), gg = hi ? bfhi(vgg[i][q]) : bflo(vgg[i][q]);
                pn[j] = pc;
                const float conv = w0[j] * p2[j] + w1[j] * p1[j] + w2[j] * pc;
                m[j] = gc * conv + (ov[j] * rstd * gn[j]) * gg;
                p2[j] = p1[j]; p1[j] = pc;
            }
            u32x4 mo; mo.x = cvt_pk_bf16(m[0], m[1]); mo.y = cvt_pk_bf16(m[2], m[3]); mo.z = cvt_pk_bf16(m[4], m[5]); mo.w = cvt_pk_bf16(m[6], m[7]);
            *(u32x4*)((bf16*)(ws + WS_MB) + row * DM + c) = mo;
            const int tp = tpos0 + t;
            if (tp >= seqlen - 2) {
                float* cs = prompt ? P.out + O_CP + ((size_t)(l * NB + seq) * 2 + (tp - (seqlen - 2))) * DM + c : P.out + O_CS + ((size_t)(l * DECB + seq) * 2 + (tp - (seqlen - 2))) * DM + c;
                *(f32x4*)(cs) = (f32x4){pn[0], pn[1], pn[2], pn[3]}; *(f32x4*)(cs + 4) = (f32x4){pn[4], pn[5], pn[6], pn[7]};
            }
        }
    }
}

__global__ void __launch_bounds__(512, 2) hybrid_fwd(Params P) {
    extern __shared__ __attribute__((aligned(16))) unsigned char lds_raw[];
    Frame F;
    F.lds = (LAS unsigned char*)lds_raw;
    F.wave = __builtin_amdgcn_readfirstlane((int)threadIdx.x >> 6);
    F.G = gridDim.x; { const int bx = blockIdx.x; F.vcu = (F.G % 8 == 0) ? (bx % 8) * (F.G / 8) + bx / 8 : bx; }
    unsigned char* ws = P.ws;
    for (int u = threadIdx.x; u < (LDS_BYTES - LDSCTL_OFF) / 4; u += 512) ((LAS unsigned*)(F.lds + LDSCTL_OFF))[u] = 0u;
    __syncthreads();
    XcdBarrier bar = xcd_barrier_post((unsigned*)(ws + WS_CTL) + CW_BAR, (volatile LAS unsigned*)(F.lds + MISC_OFF) + 8);
    const int gw = F.vcu * 8 + F.wave, NGW = F.G * 8;
#define GRID_BAR() xcd_barrier(bar)
#define STAMP(k) do { if (STAMP_A >= 0 && threadIdx.x == 0) __hip_atomic_fetch_max((unsigned long long*)((unsigned*)(ws + WS_CTL) + CW_STAMP) + (k), (unsigned long long)__builtin_amdgcn_s_memrealtime(), __ATOMIC_RELAXED, __HIP_MEMORY_SCOPE_AGENT); } while (0)

#if DBG_STAGE < 99
    { const size_t gt = (size_t)blockIdx.x * 512 + otid(), NGT = (size_t)F.G * 512; f32x4* o4 = (f32x4*)P.out; for (size_t i = gt; i < O_END / 4; i += NGT) o4[i] = (f32x4){0.f, 0.f, 0.f, 0.f}; }
    GRID_BAR();
#endif
    REP(0) { p0_prologue(F, P); __syncthreads(); }
    GRID_BAR();

#pragma unroll
    for (int l = 0; l < DEPTH; ++l) {
        if (DBG_STAGE < 99 && l > 0 && DBG_STAGE < 10) break;
        REP(5) { pg8::Gemm g{(const bf16*)(ws + WS_HB), (const bf16*)(ws + WS_WIN) + (size_t)l * NPROJ * DM, MP, NPROJ, DM}; pg8::StaticOrder S; S.init(MP, NPROJ, DM, F.G, (int)blockIdx.x);
          pg8::EpiInProj E{(bf16*)(ws + WS_PB), (bf16*)(ws + WS_GCB), (bf16*)(ws + WS_GGB), (bf16*)(ws + WS_QKV), QP};
          pg8::gemm_phase<pg8::EpiInProj, pg8::StaticOrder, true, true, true>(F.lds, g, S, E); }
        GRID_BAR();
        { const int lane = otid() & 63;
          { const bool chainblk = (F.vcu & 3) == 0 && (F.vcu >> 2) < NB * NH * 4;
            const int wi = F.vcu - (F.vcu >> 2) - 1, NW = F.G - NB * NH * 4;
            unsigned* pf = (unsigned*)(ws + WS_CTL) + CW_PREP + l * CW_PREP_L;
            for (int k = F.vcu; k < NPCH * NH; k = (k < F.G) ? F.G + wi : k + NW) { const int c = k >> 4, nn = (k >> 2) & 3, hh = k & 3;
                gla_prep_unit(F, P, l, nn * NCHUNK + c, hh);
                asm volatile("s_waitcnt vmcnt(0)" ::: "memory"); __syncthreads();
                if (F.wave == 0) (void)__hip_atomic_fetch_add(pf + (nn * NH + hh) * 64 + c, lane == 0 ? 1u : 0u, __ATOMIC_RELAXED, __HIP_MEMORY_SCOPE_AGENT);
                if (chainblk) break; }
            if (chainblk) { gla_prompt_block(F, P, l, F.vcu >> 2, lane); asm volatile("s_waitcnt vmcnt(0) lgkmcnt(0)" ::: "memory"); __syncthreads(); } }
          unsigned* qhead = (unsigned*)(ws + WS_CTL) + CW_QUEUE + 64 * l;
          volatile LAS int* isl = (volatile LAS int*)(F.lds + LDSCTL_OFF + 192);
          for (;;) {
              if (F.wave == 0) { const int v_ = (int)__hip_atomic_fetch_add(qhead, lane == 0 ? 1u : 0u, __ATOMIC_RELAXED, __HIP_MEMORY_SCOPE_AGENT); isl[0] = __builtin_amdgcn_readfirstlane(v_); }
              asm volatile("s_waitcnt vmcnt(0) lgkmcnt(0)" ::: "memory"); __syncthreads();
              const int it = isl[0];
              __syncthreads();
              if (it >= DECB * NH) break;
              gla_sample_block(F, P, l, it, (int)threadIdx.x, lane); }
          asm volatile("s_waitcnt vmcnt(0) lgkmcnt(0)" ::: "memory"); __syncthreads();
          constexpr int MG_CF = 30, MG_NC = 8 * MG_CF, MG_NP = MG_NC + (NCHUNK - MG_CF) * 32, MG_NT = MG_NP + 64;
          unsigned* qhead2 = (unsigned*)(ws + WS_CTL) + CW_QUEUE + 64 * (2 + l);
          volatile LAS int* gsl = (volatile LAS int*)(F.lds + LDSCTL_OFF + 64);
          unsigned* tmo = (unsigned*)(ws + WS_CTL) + CW_TMO;
          for (;;) {
              if (threadIdx.x == 0) { const int g = (int)__hip_atomic_fetch_add(qhead2, 1u, __ATOMIC_RELAXED, __HIP_MEMORY_SCOPE_AGENT);
                  if (g < MG_NT) { unsigned spins = 0; const bool prm = g < MG_NP;
                      int cc, nn; if (g < MG_NC) { cc = g >> 3; nn = (g >> 1) & 3; } else { const int f = g - MG_NC; cc = MG_CF + (f >> 5); nn = (f >> 3) & 3; }
                      for (int k = 0; k < (prm ? 4 : 8); ++k) {
                          const unsigned* cw = prm ? (const unsigned*)(ws + WS_CTL) + CW_CHK + l * CW_CHK_L + ((nn * NH + k) * NCHUNK + cc) * 64
                                                   : (const unsigned*)(ws + WS_CTL) + CW_SMP + l * CW_SMP_L + ((g - MG_NP) * 8 + k) * 16;
                          while (__hip_atomic_load(cw, __ATOMIC_RELAXED, __HIP_MEMORY_SCOPE_AGENT) < 4u) { __builtin_amdgcn_s_sleep(16);
                              if ((++spins & 1023u) == 0u) { if (__hip_atomic_load(tmo, __ATOMIC_RELAXED, __HIP_MEMORY_SCOPE_AGENT) != 0u) break; if (spins > (1u << 17)) { __hip_atomic_store(tmo, 1u, __ATOMIC_RELAXED, __HIP_MEMORY_SCOPE_AGENT); break; } } } }
                      __builtin_amdgcn_fence(__ATOMIC_ACQUIRE, "agent"); asm volatile("s_waitcnt vmcnt(0)" ::: "memory"); }
                  gsl[0] = g; }
              asm volatile("s_waitcnt lgkmcnt(0)" ::: "memory"); __syncthreads();
              const int g = gsl[0];
              __syncthreads();
              if (g >= MG_NT) break;
              { int r0, nrun, tp0, slen, sq, hh; bool pr, act = true;
                if (g < MG_NC) { const int c = g >> 3, n = (g >> 1) & 3, k = F.wave + 8 * (g & 1); pr = true; slen = LP; sq = n; nrun = 16;
                    if (c == 0) { act = k < 4; hh = k & 3; tp0 = 0; } else { hh = k & 3; tp0 = NMETA + 64 * (c - 1) + 16 * (k >> 2); }
                    r0 = n * LP + tp0; }
                else if (g < MG_NP) { const int f = g - MG_NC, c = MG_CF + (f >> 5), n = (f >> 3) & 3, v = (f & 7) * 8 + F.wave; pr = true; slen = LP; sq = n; nrun = 4;
                    hh = v & 3; tp0 = NMETA + 64 * (c - 1) + 4 * (v >> 2); r0 = n * LP + tp0; }
                else { const int v = (g - MG_NP) * 8 + F.wave; hh = v & 3; sq = v >> 2; pr = false; slen = DECS; nrun = DECS; tp0 = 0; r0 = NPROMPT + sq * DECS; }
                if (act) merge_unit(P, l, r0, nrun, tp0, slen, pr, sq, hh, lane); }
          } }
        GRID_BAR();
        if (DBG_STAGE < 3) continue;
        REP(6) { pg8::Gemm g{(const bf16*)(ws + WS_MB), (const bf16*)(ws + WS_WO) + (size_t)l * DM * DM, MP, DM, DM}; pg8::TailSplitOrder S; S.init(MP, DM, DM, F.G, (int)blockIdx.x);
          pg8::EpiResBf16 E{(bf16*)(ws + WS_TF), (const bf16*)(ws + WS_HB), DM, ALPHA, (float*)(ws + WS_PART)};
          pg8::gemm_phase<pg8::EpiResBf16, pg8::TailSplitOrder, true, true>(F.lds, g, S, E); }
        GRID_BAR();
        REP(4) { const int lane = otid() & 63; for (int m = gw; m < NTOK; m += NGW) ln_row_bf((const bf16*)(ws + WS_TF) + (size_t)m * DM, P.in[I_LN1W] + (size_t)l * DM, P.in[I_LN1B] + (size_t)l * DM, nullptr, (bf16*)(ws + WS_HB) + (size_t)m * DM, lane,
                   (F.G == 256 && m >= 8192) ? (const float*)((const bf16*)(ws + WS_PART) + (size_t)((m >> 8) - 32) * 64 * 65536 + (size_t)(m & 255) * 256) : nullptr); }
        GRID_BAR();
        REP(7) { pg8::Gemm g{(const bf16*)(ws + WS_HB), (const bf16*)(ws + WS_W1) + (size_t)l * DFF * DM, MP, DFF, DM}; pg8::StaticOrder S; S.init(MP, DFF, DM, F.G, (int)blockIdx.x);
          pg8::EpiBf16<1> E{(bf16*)(ws + WS_RB), DFF};
          pg8::gemm_phase<pg8::EpiBf16<1>, pg8::StaticOrder, true, true, true>(F.lds, g, S, E); }
        GRID_BAR();
        REP(8) { pg8::Gemm g{(const bf16*)(ws + WS_RB), (const bf16*)(ws + WS_W2) + (size_t)l * DM * DFF, MP, DM, DFF}; pg8::TailSplitOrder S; S.init(MP, DM, DFF, F.G, (int)blockIdx.x);
          pg8::EpiResBf16 E{(bf16*)(ws + WS_TF), (const bf16*)(ws + WS_HB), DM, ALPHA, (float*)(ws + WS_PART)};
          pg8::gemm_phase<pg8::EpiResBf16, pg8::TailSplitOrder, true, true>(F.lds, g, S, E); }
        GRID_BAR();
        { const int lane = otid() & 63;
        for (int m = gw; m < NTOK; m += NGW) {
            const bf16* src = (const bf16*)(ws + WS_TF) + (size_t)m * DM; const float* lw = P.in[I_LN2W] + (size_t)l * DM; const float* lb = P.in[I_LN2B] + (size_t)l * DM;
            const float* part = (F.G == 256 && m >= 8192) ? (const float*)((const bf16*)(ws + WS_PART) + (size_t)((m >> 8) - 32) * 64 * 65536 + (size_t)(m & 255) * 256) : nullptr;
            if (l < DEPTH - 1) ln_row_bf(src, lw, lb, nullptr, (bf16*)(ws + WS_HB) + (size_t)m * DM, lane, part);
            else { float* dst;
                if (m < NPROMPT) { const int b = m / LP, t = m % LP; if (t < NMETA) continue; dst = P.out + O_YP + ((size_t)b * SEQ + (t - NMETA)) * DM; }
                else dst = P.out + O_YS + (size_t)(m - NPROMPT) * DM;
                ln_row_bf(src, lw, lb, dst, nullptr, lane, part); }
        } }
        if (l < DEPTH - 1) GRID_BAR();
    }
#if STAMP_A >= 0
    GRID_BAR();
    { const unsigned long long* ts = (const unsigned long long*)((unsigned*)(ws + WS_CTL) + CW_STAMP);
      const unsigned long long ta = __hip_atomic_load(ts + STAMP_A, __ATOMIC_RELAXED, __HIP_MEMORY_SCOPE_AGENT), tb = __hip_atomic_load(ts + STAMP_B, __ATOMIC_RELAXED, __HIP_MEMORY_SCOPE_AGENT);
      const float Bv = floorf((float)(long long)(tb - ta) * 0.01f * (1.0f / STAMP_Q) + 0.5f) * STAMP_Q;
      for (size_t i = (size_t)blockIdx.x * 512 + threadIdx.x; i < (size_t)NSAMP * DM; i += (size_t)F.G * 512) P.out[O_YS + i] = Bv; }
#endif
}

extern "C" void kernel_launch(void* const* d_in, const int* in_sizes, int n_in, void* d_out, int out_size, void* d_ws, size_t ws_size, hipStream_t stream) {
    static int grid = 0;
    if (grid == 0) {
        if (n_in != 19 || (size_t)out_size != O_END || ws_size < WS_END) { fprintf(stderr, "kernel_launch: unexpected shapes n_in %d out %d ws %zu\n", n_in, out_size, ws_size); grid = -1; return; }
        int dev = 0, cus = 0, per_cu = 0;
        if (hipGetDevice(&dev) != hipSuccess || hipDeviceGetAttribute(&cus, hipDeviceAttributeMultiprocessorCount, dev) != hipSuccess) { grid = -1; return; }
        if (hipFuncSetAttribute((const void*)hybrid_fwd, hipFuncAttributeMaxDynamicSharedMemorySize, LDS_BYTES) != hipSuccess) { fprintf(stderr, "kernel_launch: hipFuncSetAttribute failed\n"); grid = -1; return; }
        if (hipOccupancyMaxActiveBlocksPerMultiprocessor(&per_cu, (const void*)hybrid_fwd, 512, LDS_BYTES) != hipSuccess || per_cu < 1) fprintf(stderr, "kernel_launch: occupancy query says %d\n", per_cu);
        (void)hipGetLastError();
        grid = cus;
    }
    if (grid < 0) return;
    if (hipMemsetAsync((char*)d_ws + WS_CTL, 0, CTL_ZERO_BYTES, stream) != hipSuccess) return;
    Params p{};
    for (int i = 0; i < 19; ++i) p.in[i] = (const float*)d_in[i];
    p.out = (float*)d_out; p.ws = (unsigned char*)d_ws; p.dbg = 0; p.pad = 0;
    hipLaunchKernelGGL(hybrid_fwd, dim3(grid), dim3(512), LDS_BYTES, stream, p);
}
```

```cpp
#include <hip/hip_runtime.h>
#include <cstdio>
#include <cstdint>

#define GAS __attribute__((address_space(1)))
#define LAS __attribute__((address_space(3)))
typedef unsigned short bf16;
typedef short bf16x8 __attribute__((ext_vector_type(8)));
typedef float f32x4 __attribute__((ext_vector_type(4)));
typedef float f32x2 __attribute__((ext_vector_type(2)));
typedef unsigned u32x4 __attribute__((ext_vector_type(4)));
typedef unsigned u32x2 __attribute__((ext_vector_type(2)));

#ifndef DBG_STAGE
#define DBG_STAGE 99
#endif
#ifndef PROBE_REP
#define PROBE_REP 0
#endif
#ifndef STAMP_Q
#define STAMP_Q 16.0f
#endif
#ifndef STAMP_A
#define STAMP_A -1
#endif
#ifndef STAMP_B
#define STAMP_B -1
#endif
#define REP(bit) for (int rep_ = 0; rep_ < 1 + ((PROBE_REP >> (bit)) & 1); ++rep_)

constexpr int DM = 2048, NB = 4, SEQ = 2048, NMETA = 16, LP = SEQ + NMETA, NPROMPT = NB * LP;
constexpr int DECB = 128, DECS = 4, NSAMP = DECB * DECS, NTOK = NPROMPT + NSAMP, MP = 8960;
constexpr int DEPTH = 2, NH = 4, DK = 256, DV = 512, HK = 1024, HV = 2048, RANK = 16, DFF = 8192;
constexpr int DIN = 16400, NPROJ = 16640;
constexpr int W_A1 = 16384;
constexpr int QP = 4352, C_Q = 0, C_K = 1024, C_V = 2048, C_A1 = 4096;
constexpr int NCHUNK = 33, NPCH = NB * NCHUNK;
constexpr float LN_EPS = 1e-5f;
constexpr float ALPHA = 1.41421356237f;
constexpr size_t O_YP = 0, O_YS = 16777216, O_CP = 17825792, O_GP = 17858560, O_CS = 22052864, O_GS = 23101440, O_END = 157319168;

constexpr size_t MiB = 1u << 20;
constexpr size_t WS_CTL = 0, CTL_ZERO_BYTES = 1 * MiB;
constexpr size_t WS_WIN = 1 * MiB, WS_WO = 131 * MiB, WS_W1 = 147 * MiB, WS_W2 = 211 * MiB;
constexpr size_t WS_PB = 450 * MiB, WS_GCB = 485 * MiB, WS_GGB = 520 * MiB, WS_QKV = 555 * MiB;
constexpr size_t WS_HF = 275 * MiB, WS_HB = 345 * MiB, WS_TF = 380 * MiB, WS_PROJ = 450 * MiB, WS_MB = 735 * MiB, WS_RB = 770 * MiB, WS_OB = 910 * MiB;
constexpr size_t WS_QF = 980 * MiB, WS_KTF = 997 * MiB, WS_AF = 1014 * MiB, WS_VTF = 1019 * MiB, WS_EB = 1052 * MiB, WS_PART = 1053 * MiB  , WS_END = 1101 * MiB;
constexpr int CW_BAR = 4096, CW_QUEUE = 8192, CW_STAMP = 12288;
constexpr int CW_TMO = 64;
constexpr int CW_CHK = 16384, CW_CHK_L = 40960;
constexpr int CW_PREP = 131072, CW_PREP_L = 1024;
constexpr int CW_SMP = 98304, CW_SMP_L = 8192;

constexpr int RING_BYTES = 131072, LDSCTL_OFF = 139264  , MISC_OFF = LDSCTL_OFF + 320, LDS_BYTES = 147456;

#define LDS_WAIT() asm volatile("s_waitcnt lgkmcnt(0)" ::: "memory")
#define VM_WAIT() asm volatile("s_waitcnt vmcnt(0)" ::: "memory")
__device__ __forceinline__ unsigned cvt_pk_bf16(float lo, float hi) { unsigned r; asm volatile("v_cvt_pk_bf16_f32 %0, %1, %2" : "=v"(r) : "v"(lo), "v"(hi)); return r; }
__device__ __forceinline__ float bf2f(unsigned u16v) { return __uint_as_float(u16v << 16); }
__device__ __forceinline__ float bflo(unsigned w) { return __uint_as_float(w << 16); }
__device__ __forceinline__ float bfhi(unsigned w) { return __uint_as_float(w & 0xffff0000u); }
__device__ __forceinline__ bf16 f2bf(float f) { unsigned u = __float_as_uint(f); return (bf16)((u + 0x7fffu + ((u >> 16) & 1u)) >> 16); }
__device__ __forceinline__ float wave_sum(float v) {
#pragma unroll
    for (int o = 1; o < 64; o <<= 1) v += __shfl_xor(v, o);
    return v;
}
__device__ __forceinline__ float sigmoidf_(float x) { return 1.0f / (1.0f + __expf(-x)); }
__device__ __forceinline__ float logsigmoidf_(float z) { return fminf(z, 0.f) - __logf(1.0f + __expf(-fabsf(z))); }

namespace pg8 {
#define PG8_LAS __attribute__((address_space(3)))
typedef unsigned short bf16_t;
constexpr int BM = 256, BK = 64, HALF = 128, HTB = HALF * BK * 2, STAGE_BYTES = 8 * HTB, NXCD = 8, WGM = 8;
__host__ __device__ __forceinline__ int lds_byte(int r, int c) { const int st = (r >> 4) * 2 + (c >> 5), rr = r & 15, cc = c & 31, ob = rr * 64 + cc * 2; return st * 1024 + (ob ^ (((ob >> 9) & 1) << 5)); }
__host__ __device__ __forceinline__ void stage_rc(int b, int& R, int& C) { const int st = b / 1024, sb = b % 1024, swz = sb ^ (((sb >> 9) & 1) << 5); R = (st >> 1) * 16 + swz / 64; C = (st & 1) * 32 + (swz % 64) / 2; }
__host__ __device__ __forceinline__ int perm32(int rho) { const int n = rho >> 4, i = rho & 15; return 8 * (i >> 2) + 4 * n + (i & 3); }
struct Unit { int pm, pn, kb, kn, part; };
struct Gemm { const bf16_t* A; const bf16_t* Bt; int M, N, K; };
struct StaticOrder {
    int nM, nN, nwg, G, c, nt;
    __host__ __device__ void init(int M, int N, int K, int G_, int c_) { nM = M / BM; nN = N / BM; nwg = nM * nN; G = G_; c = c_; nt = K / BK; }
    __host__ __device__ bool next(int i, Unit& u) const {
        const long L = (long)i * G + c; if (L >= nwg) return false;
        int wgid = (int)L; { const int q = nwg / NXCD, r = nwg % NXCD, xcd = wgid % NXCD, off = wgid / NXCD; wgid = (xcd < r ? xcd * (q + 1) : r * (q + 1) + (xcd - r) * q) + off; }
        const int nig = WGM * nN, gid = wgid / nig, fm = gid * WGM, gsz = (nM - fm) < WGM ? (nM - fm) : WGM;
        u.pm = fm + ((wgid % nig) % gsz); u.pn = (wgid % nig) / gsz; u.kb = 0; u.kn = nt; u.part = -1; return true;
    }
    __device__ __forceinline__ void a_ready(const Unit&) const {}
    __device__ __forceinline__ void done(const Unit&) const {}
};
struct TailSplitOrder {
    int G, c, nt, nN, nwg;
    __host__ __device__ void init(int M, int N, int K, int G_, int c_) { G = G_; c = c_; nt = K / BK; nN = N / BM; nwg = (M / BM) * nN; }
    __host__ __device__ bool split() const { return G == 256 && nN == 8 && nwg == 280 && (nt % 16) == 0; }
    __host__ __device__ bool next(int i, Unit& u) const {
        if (split()) { const int x = c & 7, j = c >> 3;
            if (i == 0) { u.pm = 4 * x + (j >> 3); u.pn = j & 7; u.kb = 0; u.kn = nt; u.part = -1; return true; }
            if (i == 1 && j < 24) { u.pm = 32 + (j >> 3); u.pn = j & 7; u.kb = x * (nt >> 3); u.kn = nt >> 3; u.part = j * 8 + x; return true; }
            return false; }
        const long L = (long)i * G + c; if (L >= nwg) return false;
        u.pm = (int)(L / nN); u.pn = (int)(L % nN); u.kb = 0; u.kn = nt; u.part = -1; return true;
    }
    __device__ __forceinline__ void a_ready(const Unit&) const {}
    __device__ __forceinline__ void done(const Unit&) const {}
};
template <int ACT  > struct EpiBf16 {
    static constexpr bool PERM = true, AFTER_DRAIN = false;
    bf16_t* O; int ldc;
    __device__ __forceinline__ void operator()(const f32x4 (&acc)[2][2][4][2], const Unit& u, int wr, int wc, int fr, int fq) const {
        const int row0 = u.pm * BM + wr * 64 + fr; const int col0 = u.pn * BM + wc * 32 + 8 * fq;
#pragma unroll
        for (int ai = 0; ai < 2; ++ai)
#pragma unroll
            for (int m = 0; m < 4; ++m) { bf16_t* rowp = O + (size_t)(row0 + ai * HALF + m * 16) * ldc + col0;
#pragma unroll
                for (int bj = 0; bj < 2; ++bj) { f32x4 v0 = acc[ai][bj][m][0], v1 = acc[ai][bj][m][1];
                    if (ACT == 1) {
#pragma unroll
                        for (int j = 0; j < 4; ++j) { const float a = fmaxf(v0[j], 0.f), b = fmaxf(v1[j], 0.f); v0[j] = a * a; v1[j] = b * b; } }
                    u32x4 w; w.x = cvt_pk_bf16(v0[0], v0[1]); w.y = cvt_pk_bf16(v0[2], v0[3]); w.z = cvt_pk_bf16(v1[0], v1[1]); w.w = cvt_pk_bf16(v1[2], v1[3]);
                    *(u32x4*)(rowp + bj * HALF) = w; } }
    }
};
struct EpiInProj {
    static constexpr bool PERM = true, AFTER_DRAIN = false;
    bf16_t* PB; bf16_t* GCB; bf16_t* GGB; bf16_t* QKV; int qp;
    __device__ __forceinline__ static float sig(float x) { return __builtin_amdgcn_rcpf(1.0f + __expf(-x)); }
    __device__ __forceinline__ void operator()(const f32x4 (&acc)[2][2][4][2], const Unit& u, int wr, int wc, int fr, int fq) const {
        const int row0 = u.pm * BM + wr * 64 + fr;
        if (u.pn >= 48) {
            const int col0 = (u.pn - 48) * BM + wc * 32 + 8 * fq;
#pragma unroll
            for (int ai = 0; ai < 2; ++ai)
#pragma unroll
                for (int m = 0; m < 4; ++m) { bf16_t* rowp = QKV + (size_t)(row0 + ai * HALF + m * 16) * qp + col0;
#pragma unroll
                    for (int bj = 0; bj < 2; ++bj) { const f32x4 v0 = acc[ai][bj][m][0], v1 = acc[ai][bj][m][1];
                        u32x4 w; w.x = cvt_pk_bf16(v0[0], v0[1]); w.y = cvt_pk_bf16(v0[2], v0[3]); w.z = cvt_pk_bf16(v1[0], v1[1]); w.w = cvt_pk_bf16(v1[2], v1[3]);
                        *(u32x4*)(rowp + bj * HALF) = w; } }
            return; }
        const int type = u.pn >> 4, col0 = (u.pn & 15) * HALF + wc * 32 + 8 * fq;
#define EIP_TILE(O_, EXPR_) do { _Pragma("unroll") for (int ai = 0; ai < 2; ++ai) _Pragma("unroll") for (int m = 0; m < 4; ++m) { float r[8]; \
            _Pragma("unroll") for (int n = 0; n < 2; ++n) _Pragma("unroll") for (int j = 0; j < 4; ++j) { const float x = acc[ai][0][m][n][j], y = acc[ai][1][m][n][j]; r[4 * n + j] = (EXPR_); } \
            u32x4 w; w.x = cvt_pk_bf16(r[0], r[1]); w.y = cvt_pk_bf16(r[2], r[3]); w.z = cvt_pk_bf16(r[4], r[5]); w.w = cvt_pk_bf16(r[6], r[7]); \
            *(u32x4*)((O_) + (size_t)(row0 + ai * HALF + m * 16) * 2048 + col0) = w; } } while (0)
        if (type == 0) EIP_TILE(PB, x * y);
        else if (type == 1) EIP_TILE(GCB, x * sig(y));
        else EIP_TILE(GGB, x * sig(x) * sig(y));
#undef EIP_TILE
    }
};
struct EpiResBf16 {
    static constexpr bool PERM = true, AFTER_DRAIN = false;
    bf16_t* T; const bf16_t* res; int ldc; float alpha; float* part_buf;
    __device__ __forceinline__ void operator()(const f32x4 (&acc)[2][2][4][2], const Unit& u, int wr, int wc, int fr, int fq) const {
        const int lrow0 = wr * 64 + fr, lcol0 = wc * 32 + 8 * fq;
        const int row0 = u.pm * BM + lrow0, col0 = u.pn * BM + lcol0;
        const bool withres = (u.part < 0) || (u.kb == 0);
        bf16_t* pb = (bf16_t*)part_buf + (size_t)(u.part < 0 ? 0 : u.part) * 65536;
        u32x4 rr[2][4][2];
#pragma unroll
        for (int ai = 0; ai < 2; ++ai)
#pragma unroll
            for (int m = 0; m < 4; ++m)
#pragma unroll
                for (int bj = 0; bj < 2; ++bj) rr[ai][m][bj] = withres ? *(const u32x4*)(res + (size_t)(row0 + ai * HALF + m * 16) * ldc + col0 + bj * HALF) : (u32x4){0u, 0u, 0u, 0u};
        bf16_t* dst = (u.part >= 0) ? pb + lrow0 * 256 + lcol0 : T + (size_t)row0 * ldc + col0;
        const size_t dpitch = (u.part >= 0) ? (size_t)256 : (size_t)ldc;
#pragma unroll
        for (int ai = 0; ai < 2; ++ai)
#pragma unroll
            for (int m = 0; m < 4; ++m)
#pragma unroll
                for (int bj = 0; bj < 2; ++bj) { f32x4 v0 = acc[ai][bj][m][0], v1 = acc[ai][bj][m][1]; const u32x4 r = rr[ai][m][bj];
                    v0 += (f32x4){__uint_as_float(r.x << 16), __uint_as_float(r.x & 0xffff0000u), __uint_as_float(r.y << 16), __uint_as_float(r.y & 0xffff0000u)} * alpha;
                    v1 += (f32x4){__uint_as_float(r.z << 16), __uint_as_float(r.z & 0xffff0000u), __uint_as_float(r.w << 16), __uint_as_float(r.w & 0xffff0000u)} * alpha;
                    u32x4 w; w.x = cvt_pk_bf16(v0[0], v0[1]); w.y = cvt_pk_bf16(v0[2], v0[3]); w.z = cvt_pk_bf16(v1[0], v1[1]); w.w = cvt_pk_bf16(v1[2], v1[3]);
                    *(u32x4*)(dst + (size_t)(ai * HALF + m * 16) * dpitch + bj * HALF) = w; }
    }
};
struct EpiResF32 {
    static constexpr bool PERM = false, AFTER_DRAIN = false;
    float* C; const float* res; int ldc; float alpha; float* part_buf;
    __device__ __forceinline__ void operator()(const f32x4 (&acc)[2][2][4][2], const Unit& u, int wr, int wc, int fr, int fq) const {
        const int lrow0 = wr * 64 + fr, lcol0 = wc * 32 + 4 * fq;
        const int row0 = u.pm * BM + lrow0, col0 = u.pn * BM + lcol0;
        if (u.part >= 0) {
            float* pb = part_buf + (size_t)u.part * 65536; const float a0 = (u.kb == 0) ? alpha : 0.f;
#pragma unroll
            for (int ai = 0; ai < 2; ++ai)
#pragma unroll
                for (int m = 0; m < 4; ++m) { const size_t off = (size_t)(row0 + ai * HALF + m * 16) * ldc + col0; const int loff = (lrow0 + ai * HALF + m * 16) * 256 + lcol0;
#pragma unroll
                    for (int bj = 0; bj < 2; ++bj)
#pragma unroll
                        for (int n = 0; n < 2; ++n) { f32x4 v = acc[ai][bj][m][n]; if (u.kb == 0) { const f32x4 r = *(const f32x4*)(res + off + bj * HALF + n * 16); v = r * a0 + v; } *(f32x4*)(pb + loff + bj * HALF + n * 16) = v; } }
            return; }
#pragma unroll
        for (int ai = 0; ai < 2; ++ai)
#pragma unroll
            for (int m = 0; m < 4; ++m) { const size_t off = (size_t)(row0 + ai * HALF + m * 16) * ldc + col0;
#pragma unroll
                for (int bj = 0; bj < 2; ++bj)
#pragma unroll
                    for (int n = 0; n < 2; ++n) { const f32x4 r = *(const f32x4*)(res + off + bj * HALF + n * 16); *(f32x4*)(C + off + bj * HALF + n * 16) = r * alpha + acc[ai][bj][m][n]; } }
    }
};

template <class Epi, class Sched, bool ALIGN_EPI = false, bool SP2 = false, bool SERP = false>
__device__ __forceinline__ void gemm_phase(PG8_LAS unsigned char* lds, const Gemm g, const Sched& S, const Epi& E) {
    int tid_ = threadIdx.x; asm volatile("" : "+v"(tid_));
    const int tid = tid_, wid = __builtin_amdgcn_readfirstlane(tid >> 6), lane = tid & 63, wr = wid >> 2, wc = wid & 3, fr = lane & 15, fq = lane >> 4;
    const int K = g.K;
    unsigned voffA[2], voffB[2];
#pragma unroll
    for (int i = 0; i < 2; ++i) { int R, C; stage_rc(tid * 16 + i * 8192, R, C); const int Rb = Epi::PERM ? ((R & ~31) + perm32(R & 31)) : R;
        voffA[i] = (unsigned)(R * K + C) * 2u; voffB[i] = (unsigned)(Rb * K + C) * 2u; }
    const size_t kstep = (size_t)(BK * 2);
    const size_t hstep = (size_t)HALF * K * 2;
    const size_t tstep = 2 * hstep;
    const unsigned ldsw = (unsigned)wid * 1024u;
    const int aoff = lds_byte(wr * 64 + fr, fq * 8), boff = lds_byte(wc * 32 + fr, fq * 8);
#define PG8_SA(b, h) (((b) * 2 + (h)) * HTB)
#define PG8_SB(b, h) ((4 + (b) * 2 + (h)) * HTB)
#define PG8_STAGE(bufoff, gbase, voff) do { _Pragma("unroll") for (int _i = 0; _i < 2; ++_i) \
        __builtin_amdgcn_global_load_lds((const unsigned*)((const char*)(gbase) + (voff)[_i]), (PG8_LAS unsigned*)(lds + (bufoff) + ldsw + _i * 8192), 16, 0, 0); } while (0)
#define PG8_LDA(dst, b, h) do { _Pragma("unroll") for (int m = 0; m < 4; ++m) _Pragma("unroll") for (int k = 0; k < 2; ++k) dst[m][k] = *(const PG8_LAS bf16x8*)(lds + PG8_SA(b, h) + aoff + m * 2048 + k * 1024); } while (0)
#define PG8_LDB(dst, b, h) do { _Pragma("unroll") for (int n = 0; n < 2; ++n) _Pragma("unroll") for (int k = 0; k < 2; ++k) dst[n][k] = *(const PG8_LAS bf16x8*)(lds + PG8_SB(b, h) + boff + n * 2048 + k * 1024); } while (0)
#define PG8_MMA(ai, bj, At, Bt) do { __builtin_amdgcn_s_setprio(1); _Pragma("unroll") for (int m = 0; m < 4; ++m) _Pragma("unroll") for (int n = 0; n < 2; ++n) _Pragma("unroll") for (int k = 0; k < 2; ++k) \
        acc[ai][bj][m][n] = __builtin_amdgcn_mfma_f32_16x16x32_bf16(Bt[n][k], At[m][k], acc[ai][bj][m][n], 0, 0, 0); __builtin_amdgcn_s_setprio(0); } while (0)
#define PG8_WAIT_V(n) asm volatile("s_waitcnt vmcnt(" #n ")" ::: "memory")
#define PG8_WAIT_L(n) asm volatile("s_waitcnt lgkmcnt(" #n ")" ::: "memory")
#define PG8_BAR __builtin_amdgcn_s_barrier()
#define PG8_SCHED __builtin_amdgcn_sched_barrier(0)
    Unit cur, nxt; int ui = 0;
    if (!S.next(0, cur)) return;
    f32x4 acc[2][2][4][2];
#pragma unroll
    for (int a = 0; a < 2; ++a)
#pragma unroll
        for (int b = 0; b < 2; ++b)
#pragma unroll
            for (int m = 0; m < 4; ++m)
#pragma unroll
                for (int n = 0; n < 2; ++n) acc[a][b][m][n] = (f32x4){0.f, 0.f, 0.f, 0.f};
    bf16x8 At[4][2], B0[2][2], B1[2][2];
    const char* cA = (const char*)g.A + (size_t)cur.pm * tstep + (size_t)cur.kb * kstep; const char* cB = (const char*)g.Bt + (size_t)cur.pn * tstep + (size_t)cur.kb * kstep;
    S.a_ready(cur);
    if constexpr (SP2) {
        PG8_STAGE(PG8_SB(0, 0), cB, voffB); PG8_STAGE(PG8_SB(0, 1), cB + hstep, voffB); PG8_STAGE(PG8_SA(0, 0), cA, voffA); PG8_STAGE(PG8_SA(0, 1), cA + hstep, voffA);
        if (wr == 1) PG8_BAR;
        PG8_WAIT_V(2); PG8_BAR;
        PG8_STAGE(PG8_SB(1, 0), cB + kstep, voffB); PG8_STAGE(PG8_SA(1, 0), cA + kstep, voffA); PG8_STAGE(PG8_SB(1, 1), cB + hstep + kstep, voffB);
        PG8_WAIT_V(6); PG8_BAR;
    } else {
        PG8_STAGE(PG8_SB(0, 0), cB, voffB); PG8_STAGE(PG8_SA(0, 0), cA, voffA); PG8_STAGE(PG8_SB(0, 1), cB + hstep, voffB); PG8_STAGE(PG8_SA(0, 1), cA + hstep, voffA);
        if (wr == 1) PG8_BAR;
        PG8_WAIT_V(4); PG8_BAR;
        PG8_STAGE(PG8_SB(1, 0), cB + kstep, voffB); PG8_STAGE(PG8_SA(1, 0), cA + kstep, voffA); PG8_STAGE(PG8_SB(1, 1), cB + hstep + kstep, voffB);
        PG8_WAIT_V(6); PG8_BAR;
    }
    for (;;) {
        const bool has_next = S.next(ui + 1, nxt);
        const bool cdn = SERP && (ui & 1), ndn = SERP && !(ui & 1) && has_next;
        const long cst = cdn ? -(long)kstep : (long)kstep, nst = ndn ? -(long)kstep : (long)kstep;
        const size_t nk0 = (size_t)(ndn ? nxt.kb + nxt.kn - 1 : nxt.kb) * kstep;
        const char* nA = has_next ? (const char*)g.A + (size_t)nxt.pm * tstep + nk0 : cA; const char* nB = has_next ? (const char*)g.Bt + (size_t)nxt.pn * tstep + nk0 : cB;
        const int nt = cur.kn;
        for (int t = 0; t < nt; t += 2) {
            const bool last = (t == nt - 2);
            const char* a1 = cA + (long)(t + 1) * cst;
            const char* a2 = last ? nA : cA + (long)(t + 2) * cst; const char* b2 = last ? nB : cB + (long)(t + 2) * cst;
            const long st3 = last ? nst : cst;
            const char* a3 = a2 + st3; const char* b3 = b2 + st3;
            if (last && has_next) S.a_ready(nxt);
            if constexpr (SP2) {
            PG8_LDB(B0, 0, 0); PG8_LDB(B1, 0, 1); PG8_SCHED; PG8_LDA(At, 0, 0); PG8_STAGE(PG8_SA(1, 1), a1 + hstep, voffA);
            PG8_WAIT_V(8); PG8_WAIT_L(0); PG8_BAR; PG8_MMA(0, 0, At, B0); PG8_MMA(0, 1, At, B1); PG8_BAR; PG8_SCHED;
            PG8_LDA(At, 0, 1); PG8_STAGE(PG8_SB(0, 0), b2, voffB); PG8_STAGE(PG8_SB(0, 1), b2 + hstep, voffB); PG8_STAGE(PG8_SA(0, 0), a2, voffA);
            PG8_WAIT_V(8); PG8_WAIT_L(0); PG8_BAR; PG8_MMA(1, 0, At, B0); PG8_MMA(1, 1, At, B1); PG8_BAR; PG8_SCHED;
            PG8_LDB(B0, 1, 0); PG8_LDB(B1, 1, 1); PG8_SCHED; PG8_LDA(At, 1, 0); PG8_STAGE(PG8_SA(0, 1), a2 + hstep, voffA);
            PG8_WAIT_V(8); PG8_WAIT_L(0); PG8_BAR; PG8_MMA(0, 0, At, B0); PG8_MMA(0, 1, At, B1); PG8_BAR; PG8_SCHED;
            PG8_LDA(At, 1, 1); PG8_STAGE(PG8_SB(1, 0), b3, voffB); PG8_STAGE(PG8_SB(1, 1), b3 + hstep, voffB); PG8_STAGE(PG8_SA(1, 0), a3, voffA);
            PG8_WAIT_V(8); PG8_WAIT_L(0); PG8_BAR; PG8_MMA(1, 0, At, B0); PG8_MMA(1, 1, At, B1); PG8_BAR; PG8_SCHED;
            } else {
            PG8_LDB(B0, 0, 0); PG8_SCHED; PG8_LDA(At, 0, 0); PG8_STAGE(PG8_SA(1, 1), a1 + hstep, voffA);
            PG8_WAIT_L(8); PG8_BAR; PG8_WAIT_L(0); PG8_MMA(0, 0, At, B0); PG8_BAR; PG8_SCHED;
            PG8_LDB(B1, 0, 1); PG8_STAGE(PG8_SB(0, 0), b2, voffB);
            PG8_BAR; PG8_WAIT_L(0); PG8_MMA(0, 1, At, B1); PG8_BAR;
            PG8_LDA(At, 0, 1); PG8_STAGE(PG8_SA(0, 0), a2, voffA);
            PG8_BAR; PG8_WAIT_L(0); PG8_MMA(1, 0, At, B0); PG8_BAR; PG8_SCHED;
            PG8_STAGE(PG8_SB(0, 1), b2 + hstep, voffB);
            PG8_WAIT_V(6); PG8_BAR; PG8_MMA(1, 1, At, B1); PG8_BAR;
            PG8_LDB(B0, 1, 0); PG8_SCHED; PG8_LDA(At, 1, 0); PG8_STAGE(PG8_SA(0, 1), a2 + hstep, voffA);
            PG8_WAIT_L(8); PG8_BAR; PG8_WAIT_L(0); PG8_MMA(0, 0, At, B0); PG8_BAR; PG8_SCHED;
            PG8_LDB(B1, 1, 1); PG8_STAGE(PG8_SB(1, 0), b3, voffB);
            PG8_BAR; PG8_WAIT_L(0); PG8_MMA(0, 1, At, B1); PG8_BAR;
            PG8_LDA(At, 1, 1); PG8_STAGE(PG8_SA(1, 0), a3, voffA);
            PG8_BAR; PG8_WAIT_L(0); PG8_MMA(1, 0, At, B0); PG8_BAR; PG8_SCHED;
            PG8_STAGE(PG8_SB(1, 1), b3 + hstep, voffB);
            PG8_WAIT_V(6); PG8_BAR; PG8_MMA(1, 1, At, B1); PG8_BAR;
            }
        }
        if constexpr (ALIGN_EPI) { if (wr == 0) PG8_BAR; }
        if constexpr (!Epi::AFTER_DRAIN) { E(acc, cur, wr, wc, fr, fq); S.done(cur); }
        if (!has_next) break;
#pragma unroll
        for (int a = 0; a < 2; ++a)
#pragma unroll
            for (int b = 0; b < 2; ++b)
#pragma unroll
                for (int m = 0; m < 4; ++m)
#pragma unroll
                    for (int n = 0; n < 2; ++n) acc[a][b][m][n] = (f32x4){0.f, 0.f, 0.f, 0.f};
        cur = nxt; cA = nA; cB = nB; ++ui;
        if constexpr (ALIGN_EPI) { if (wr == 1) PG8_BAR; }
    }
    PG8_WAIT_V(0);
    if constexpr (!ALIGN_EPI) { if (wr == 0) PG8_BAR; }
    PG8_BAR;
#undef PG8_SA
#undef PG8_SB
#undef PG8_STAGE
#undef PG8_LDA
#undef PG8_LDB
#undef PG8_MMA
#undef PG8_WAIT_V
#undef PG8_WAIT_L
#undef PG8_BAR
#undef PG8_SCHED
}
}

#define XB_TMO      128
#define XB_XCNT(j)  (256  + 64 * (j))
#define XB_XSUB(j)  (1280 + 64 * (j))
#define XB_XGEN(j)  (2304 + 64 * (j))
#define XB_TOP      3328
#define XB_TOPGEN   3392
#define XCD_BAR_WORDS 3456
#define XB_SPIN_CAP (1u << 18)
__device__ __forceinline__ unsigned xb_ld(unsigned* p)              { return __hip_atomic_load(p, __ATOMIC_RELAXED, __HIP_MEMORY_SCOPE_AGENT); }
__device__ __forceinline__ unsigned xb_add(unsigned* p, unsigned v) { return __hip_atomic_fetch_add(p, v, __ATOMIC_RELAXED, __HIP_MEMORY_SCOPE_AGENT); }
__device__ __forceinline__ unsigned xb_xcc_id() { return (unsigned)__builtin_amdgcn_s_getreg((3 << 11) | 20) & 0xFu; }
#define XB_SPIN(cond, bar) do { unsigned _sp = 0; while (cond) { __builtin_amdgcn_s_sleep(1); \
    if ((++_sp & 255u) == 0u) { if (xb_ld(&(bar)[XB_TMO])) break; if (_sp > XB_SPIN_CAP) { atomicAdd(&(bar)[XB_TMO], 1u); break; } } } } while (0)
struct XcdBarrier { unsigned* bar; unsigned x; volatile LAS unsigned* st; };
__device__ __forceinline__ XcdBarrier xcd_barrier_post(unsigned* bar, volatile LAS unsigned* st) {
    XcdBarrier b; b.bar = bar; b.x = xb_xcc_id(); b.st = st;
    if (threadIdx.x == 0) (void)xb_add(&bar[XB_XCNT(b.x)], 1u);
    return b;
}
__device__ __forceinline__ void xcd_barrier_complete(unsigned* bar, unsigned x, unsigned& nloc, unsigned& nx) {
    const unsigned G = gridDim.x * gridDim.y * gridDim.z;
    unsigned sum, cnt, mine, sp = 0u;
    for (;;) {
        sum = 0u; cnt = 0u; mine = 0u;
#pragma unroll
        for (unsigned j = 0; j < 16; ++j) { const unsigned c = xb_ld(&bar[XB_XCNT(j)]); sum += c; cnt += (c > 0u) ? 1u : 0u; mine = (j == x) ? c : mine; }
        if (sum == G) break;
        __builtin_amdgcn_s_sleep(1);
        if ((++sp & 255u) == 0u) { if (xb_ld(&bar[XB_TMO])) break; if (sp > XB_SPIN_CAP) { atomicAdd(&bar[XB_TMO], 1u); break; } }
    }
    nloc = mine > 0u ? mine : 1u; nx = cnt > 0u ? cnt : 1u;
}
__device__ __forceinline__ void xcd_barrier(const XcdBarrier& b) {
    asm volatile("s_waitcnt vmcnt(0)" ::: "memory");
    __syncthreads();
    if (threadIdx.x == 0) {
        unsigned* bar = b.bar;
        unsigned bx = b.x; asm volatile("" : "+s"(bx));
        __builtin_amdgcn_s_waitcnt(0);
        unsigned nloc = b.st[0], nx = b.st[1];
        if (nloc == 0u) { xcd_barrier_complete(bar, bx, nloc, nx); b.st[0] = nloc; b.st[1] = nx; }
        const unsigned old = xb_add(&bar[XB_XSUB(bx)], 1u);
        const unsigned gen = old / nloc;
        if (old + 1u == (gen + 1u) * nloc) {
            __builtin_amdgcn_fence(__ATOMIC_RELEASE, "agent");
            asm volatile("s_waitcnt vmcnt(0)" ::: "memory");
            const unsigned og = xb_add(&bar[XB_TOP], 1u);
            const unsigned tg = og / nx;
            if (og + 1u == (tg + 1u) * nx) xb_add(&bar[XB_TOPGEN], 1u);
            else XB_SPIN(xb_ld(&bar[XB_TOPGEN]) == tg, bar);
            __builtin_amdgcn_fence(__ATOMIC_ACQUIRE, "agent");
            xb_add(&bar[XB_XGEN(bx)], 1u);
            asm volatile("s_waitcnt vmcnt(0)" ::: "memory");
        } else {
            XB_SPIN(xb_ld(&bar[XB_XGEN(bx)]) == gen, bar);
            __builtin_amdgcn_fence(__ATOMIC_ACQUIRE, "agent");
            asm volatile("s_waitcnt vmcnt(0)" ::: "memory");
        }
    }
    __syncthreads();
}

struct Params { const float* in[19]; float* out; unsigned char* ws; int dbg; int pad; };
enum { I_XP = 0, I_XS, I_SCONV, I_SGLA, I_META, I_LNW, I_LNB, I_WIN, I_CONVW, I_WA2, I_BA2, I_GNW, I_WO, I_LN1W, I_LN1B, I_W1, I_W2, I_LN2W, I_LN2B };

struct Frame {
    LAS unsigned char* lds;
    int wave, vcu, G;
};
__device__ __forceinline__ int otid() { int t = threadIdx.x; asm volatile("" : "+v"(t)); return t; }

struct CvtItem { const float* src; bf16* dst; int ldw, K; };
__device__ __forceinline__ void cvt_load(const CvtItem& ci, f32x4 (&v)[16], int lane) {
    const int r = lane >> 4, c4 = lane & 15;
#pragma unroll
    for (int i = 0; i < 16; ++i) v[i] = *(const f32x4*)(ci.src + (size_t)(4 * i + r) * ci.ldw + 4 * c4);
}
__device__ __forceinline__ void cvt_store(const CvtItem& ci, const f32x4 (&v)[16], LAS float* scr, int lane) {
    const int r = lane >> 4, c4 = lane & 15;
#pragma unroll
    for (int i = 0; i < 16; ++i) { const int k = 4 * i + r; *(LAS f32x4*)(scr + k * 64 + ((4 * c4) ^ (((k >> 3) & 7) << 2))) = v[i]; }
    LDS_WAIT();
    const int c = lane & 7, nn = lane >> 3;
#pragma unroll
    for (int p = 0; p < 8; ++p) { const int n = 8 * p + nn; const LAS float* s = scr + (8 * c) * 64 + (n ^ (c << 2));
        u32x4 o; o.x = cvt_pk_bf16(s[0], s[64]); o.y = cvt_pk_bf16(s[128], s[192]); o.z = cvt_pk_bf16(s[256], s[320]); o.w = cvt_pk_bf16(s[384], s[448]);
        *(u32x4*)(ci.dst + (size_t)n * ci.K + 8 * c) = o; }
    LDS_WAIT();
}
__device__ __forceinline__ void ln_row(const float* xrow, const float* w, const float* b, float* of, bf16* ob, int lane, const float* part = nullptr) {
    (void)part;
    const f32x4* xr = (const f32x4*)xrow + lane;
    f32x4 wv[8], bv[8];
#pragma unroll
    for (int j = 0; j < 8; ++j) { wv[j] = ((const f32x4*)w)[lane + 64 * j]; bv[j] = ((const f32x4*)b)[lane + 64 * j]; }
    f32x4 v[8]; float s = 0.f;
#pragma unroll
    for (int j = 0; j < 8; ++j) v[j] = xr[64 * j];
#pragma unroll
    for (int j = 0; j < 8; ++j) s += (v[j].x + v[j].y) + (v[j].z + v[j].w);
    const float mean = wave_sum(s) * (1.f / DM); float s2 = 0.f;
#pragma unroll
    for (int j = 0; j < 8; ++j) { v[j] = v[j] - mean; s2 += (v[j].x * v[j].x + v[j].y * v[j].y) + (v[j].z * v[j].z + v[j].w * v[j].w); }
    const float rstd = 1.f / sqrtf(wave_sum(s2) * (1.f / DM) + LN_EPS);
#pragma unroll
    for (int j = 0; j < 8; ++j) { const f32x4 y = v[j] * rstd * wv[j] + bv[j];
        if (of) ((f32x4*)of)[lane + 64 * j] = y;
        if (ob) { u32x2 o; o.x = cvt_pk_bf16(y.x, y.y); o.y = cvt_pk_bf16(y.z, y.w); ((u32x2*)ob)[lane + 64 * j] = o; } }
}

struct Row4 { u32x4 r0, r1, r2, r3; };
__device__ __forceinline__ Row4 ln_row_load(const bf16* xrow, int lane) { Row4 q; q.r0 = *(const u32x4*)(xrow + 8 * lane); q.r1 = *(const u32x4*)(xrow + 8 * lane + 512); q.r2 = *(const u32x4*)(xrow + 8 * lane + 1024); q.r3 = *(const u32x4*)(xrow + 8 * lane + 1536); return q; }
__device__ __forceinline__ void ln_row_bf(const bf16* xrow, const float* w, const float* b, float* of, bf16* ob, int lane, const float* part, bool havepre = false, Row4 pre = Row4{}) {
    f32x4 wv[4][2], bv[4][2];
#pragma unroll
    for (int j = 0; j < 4; ++j) { const int c = 8 * lane + 512 * j; wv[j][0] = *(const f32x4*)(w + c); wv[j][1] = *(const f32x4*)(w + c + 4); bv[j][0] = *(const f32x4*)(b + c); bv[j][1] = *(const f32x4*)(b + c + 4); }
    f32x4 v[4][2]; float s = 0.f;
    if (part) {
#pragma unroll
        for (int j = 0; j < 4; ++j) { const int c = 8 * lane + 512 * j; const bf16* pp = (const bf16*)part + (size_t)((c >> 8) * 8) * 65536 + (c & 255);
            u32x4 r[8];
#pragma unroll
            for (int x = 0; x < 8; ++x) r[x] = *(const u32x4*)(pp + (size_t)x * 65536);
            f32x4 a0 = (f32x4){0.f, 0.f, 0.f, 0.f}, a1 = a0;
#pragma unroll
            for (int x = 0; x < 8; ++x) { a0 += (f32x4){bflo(r[x].x), bfhi(r[x].x), bflo(r[x].y), bfhi(r[x].y)}; a1 += (f32x4){bflo(r[x].z), bfhi(r[x].z), bflo(r[x].w), bfhi(r[x].w)}; }
            v[j][0] = a0; v[j][1] = a1; }
    } else {
        u32x4 r[4];
        if (havepre) { r[0] = pre.r0; r[1] = pre.r1; r[2] = pre.r2; r[3] = pre.r3; }
        else {
#pragma unroll
            for (int j = 0; j < 4; ++j) r[j] = *(const u32x4*)(xrow + 8 * lane + 512 * j); }
#pragma unroll
        for (int j = 0; j < 4; ++j) { v[j][0] = (f32x4){bflo(r[j].x), bfhi(r[j].x), bflo(r[j].y), bfhi(r[j].y)}; v[j][1] = (f32x4){bflo(r[j].z), bfhi(r[j].z), bflo(r[j].w), bfhi(r[j].w)}; }
    }
#pragma unroll
    for (int j = 0; j < 4; ++j) s += ((v[j][0].x + v[j][0].y) + (v[j][0].z + v[j][0].w)) + ((v[j][1].x + v[j][1].y) + (v[j][1].z + v[j][1].w));
    const float mean = wave_sum(s) * (1.f / DM); float s2 = 0.f;
#pragma unroll
    for (int j = 0; j < 4; ++j)
#pragma unroll
        for (int k = 0; k < 2; ++k) { v[j][k] = v[j][k] - mean; s2 += (v[j][k].x * v[j][k].x + v[j][k].y * v[j][k].y) + (v[j][k].z * v[j][k].z + v[j][k].w * v[j][k].w); }
    const float rstd = 1.f / sqrtf(wave_sum(s2) * (1.f / DM) + LN_EPS);
#pragma unroll
    for (int j = 0; j < 4; ++j) { const int c = 8 * lane + 512 * j;
        const f32x4 y0 = v[j][0] * rstd * wv[j][0] + bv[j][0], y1 = v[j][1] * rstd * wv[j][1] + bv[j][1];
        if (of) { *(f32x4*)(of + c) = y0; *(f32x4*)(of + c + 4) = y1; }
        if (ob) { u32x4 o; o.x = cvt_pk_bf16(y0.x, y0.y); o.y = cvt_pk_bf16(y0.z, y0.w); o.z = cvt_pk_bf16(y1.x, y1.y); o.w = cvt_pk_bf16(y1.z, y1.w); *(u32x4*)(ob + c) = o; } }
}
__device__ __forceinline__ void p0_prologue(const Frame& F, const Params& P) {
    unsigned char* ws = P.ws;
    const int tid = otid(), lane = tid & 63;
    LAS float* scr = (LAS float*)(F.lds + F.wave * 16384);
    const int gw = F.vcu * 8 + F.wave, NGW = F.G * 8;
    constexpr int I_IN = 32 * 256, I_O = 32 * 32, I_1 = 32 * 128, I_2 = 128 * 32, I_L = I_IN + I_O + I_1 + I_2;
#define CVT_DECODE(it_, ci_) do { const int l_ = (it_) / I_L; int r_ = (it_) % I_L; \
        if (r_ < I_IN) { const int kb = r_ >> 8, nb = r_ & 255; const int nd = nb * 64, T_ = nd >> 8, hf_ = (nd >> 7) & 1, ch_ = 128 * (T_ & 15) + (nd & 127); \
            const int nsrc = T_ < 16 ? (hf_ ? 4096 : 2048) + ch_ : T_ < 32 ? (hf_ ? 12304 + ch_ : ch_) : T_ < 48 ? (hf_ ? 14352 + ch_ : 10240 + ch_) : 6144 + (nd - 12288); \
            ci_.src = P.in[I_WIN] + (size_t)l_ * DM * DIN + (size_t)(kb * 64) * DIN + nsrc; ci_.ldw = DIN; ci_.dst = (bf16*)(ws + WS_WIN) + (size_t)l_ * NPROJ * DM + (size_t)nd * DM + kb * 64; ci_.K = DM; } \
        else if ((r_ -= I_IN) < I_O) { const int kb = r_ >> 5, nb = r_ & 31; ci_.src = P.in[I_WO] + (size_t)l_ * DM * DM + (size_t)(kb * 64) * DM + nb * 64; ci_.ldw = DM; ci_.dst = (bf16*)(ws + WS_WO) + (size_t)l_ * DM * DM + (size_t)(nb * 64) * DM + kb * 64; ci_.K = DM; } \
        else if ((r_ -= I_O) < I_1) { const int kb = r_ >> 7, nb = r_ & 127; ci_.src = P.in[I_W1] + (size_t)l_ * DM * DFF + (size_t)(kb * 64) * DFF + nb * 64; ci_.ldw = DFF; ci_.dst = (bf16*)(ws + WS_W1) + (size_t)l_ * DFF * DM + (size_t)(nb * 64) * DM + kb * 64; ci_.K = DM; } \
        else { r_ -= I_1; const int kb = r_ >> 5, nb = r_ & 31; ci_.src = P.in[I_W2] + (size_t)l_ * DFF * DM + (size_t)(kb * 64) * DM + nb * 64; ci_.ldw = DM; ci_.dst = (bf16*)(ws + WS_W2) + (size_t)l_ * DM * DFF + (size_t)(nb * 64) * DFF + kb * 64; ci_.K = DFF; } } while (0)
    { f32x4 va[16], vb[16], vc[16]; CvtItem ca, cb, cc; int it = gw;
      constexpr int NIT = DEPTH * I_L;
      if (it < NIT) { CVT_DECODE(it, ca); cvt_load(ca, va, lane); }
      if (it + NGW < NIT) { CVT_DECODE(it + NGW, cb); cvt_load(cb, vb, lane); }
      while (it < NIT) {
          if (it + 2 * NGW < NIT) { CVT_DECODE(it + 2 * NGW, cc); cvt_load(cc, vc, lane); }
          cvt_store(ca, va, scr, lane);
          if (it + NGW >= NIT) break;
          if (it + 3 * NGW < NIT) { CVT_DECODE(it + 3 * NGW, ca); cvt_load(ca, va, lane); }
          cvt_store(cb, vb, scr, lane);
          if (it + 2 * NGW >= NIT) break;
          if (it + 4 * NGW < NIT) { CVT_DECODE(it + 4 * NGW, cb); cvt_load(cb, vb, lane); }
          cvt_store(cc, vc, scr, lane);
          it += 3 * NGW; } }
#undef CVT_DECODE
    const int gt = F.vcu * 512 + tid, NGT = F.G * 512;
    for (int i = gt; i < DEPTH * DM * 16; i += NGT) { const int l = i / (DM * 16), r = i % (DM * 16), k = r >> 4, j = r & 15;
        ((bf16*)(ws + WS_WIN))[(size_t)l * NPROJ * DM + (size_t)(W_A1 + j) * DM + k] = f2bf(P.in[I_WIN][(size_t)l * DM * DIN + (size_t)k * DIN + 12288 + j]); }
    constexpr int ZR = NPROJ - (W_A1 + 16);
    for (int i = gt; i < DEPTH * ZR * (DM / 8); i += NGT) { const int l = i / (ZR * (DM / 8)), r = i % (ZR * (DM / 8));
        ((u32x4*)((bf16*)(ws + WS_WIN) + (size_t)l * NPROJ * DM + (size_t)(W_A1 + 16) * DM))[r] = (u32x4){0u, 0u, 0u, 0u}; }
    for (int m = gw; m < MP; m += NGW) {
        float* of = nullptr; bf16* ob = (bf16*)(ws + WS_HB) + (size_t)m * DM;
        if (m >= NTOK) { ((u32x4*)ob)[lane] = (u32x4){0u, 0u, 0u, 0u}; ((u32x4*)ob)[lane + 64] = (u32x4){0u, 0u, 0u, 0u}; ((u32x4*)ob)[lane + 128] = (u32x4){0u, 0u, 0u, 0u}; ((u32x4*)ob)[lane + 192] = (u32x4){0u, 0u, 0u, 0u}; continue; }
        const float* src;
        if (m < NPROMPT) { const int b = m / LP, t = m % LP; src = (t < NMETA) ? P.in[I_META] + (size_t)t * DM : P.in[I_XP] + ((size_t)b * SEQ + (t - NMETA)) * DM; }
        else src = P.in[I_XS] + (size_t)(m - NPROMPT) * DM;
        ln_row(src, P.in[I_LNW], P.in[I_LNB], of, ob, lane);
    }
}

constexpr int PREP_RAWQ = 0, PREP_RAWK = 32768, PREP_RAWV = 65536, PREP_QS = 65536, PREP_KS = 98304, PREP_AS = 0, PREP_A1 = 131072, PREP_TOT = 135168;
__device__ __forceinline__ int prep_swz(int r, int dk) { return r * 512 + ((((dk >> 3) ^ (r & 15)) << 4) | ((dk & 7) << 1)); }
__device__ __forceinline__ void gla_prep_unit(const Frame& F, const Params& P, int l, int ci, int h) {
    unsigned char* ws = P.ws;
    const bf16* proj = (const bf16*)(ws + WS_QKV);
    const int n = ci / NCHUNK, c = ci % NCHUNK;
    const int tok0 = (c == 0) ? 0 : NMETA + 64 * (c - 1), len = (c == 0) ? NMETA : 64, row0 = n * LP + tok0;
    const int u = ci * NH + h;
    bf16* QFb = (bf16*)(ws + WS_QF) + (size_t)u * 16384; bf16* KTFb = (bf16*)(ws + WS_KTF) + (size_t)u * 16384;
    bf16* AFb = (bf16*)(ws + WS_AF) + (size_t)u * 4096; bf16* VTFb = (bf16*)(ws + WS_VTF) + (size_t)u * 32768; float* EBb = (float*)(ws + WS_EB) + (size_t)u * 256;
    const int tid = otid(), lane = tid & 63, d = tid & 255, half = tid >> 8, w = F.wave;
    const __amdgpu_buffer_rsrc_t rsW = __builtin_amdgcn_make_buffer_rsrc((void*)ws, 0, 0x7fffffff, 0x00020000);
#define PREP_ST128(ptr_, val_) __builtin_amdgcn_raw_buffer_store_b128((val_), rsW, (unsigned)((const unsigned char*)(ptr_) - ws), 0, 16)
    LAS float* a1s = (LAS float*)(F.lds + PREP_A1);
    LAS float* tot = (LAS float*)(F.lds + PREP_TOT);
    { const char* gq = (const char*)(proj + (size_t)row0 * QP + C_Q + h * DK) + (lane & 31) * 16; const char* gk = (const char*)(proj + (size_t)row0 * QP + C_K + h * DK) + (lane & 31) * 16;
      const char* gv = (const char*)(proj + (size_t)row0 * QP + C_V + h * DV) + lane * 16;
#pragma unroll
      for (int j = 0; j < 4; ++j) { const int i = w + 8 * j; if (2 * i < len) { const size_t ro = (size_t)(2 * i + (lane >> 5)) * QP * 2;
          __builtin_amdgcn_global_load_lds((const unsigned*)(gq + ro), (LAS unsigned*)(F.lds + PREP_RAWQ + i * 1024), 16, 0, 0);
          __builtin_amdgcn_global_load_lds((const unsigned*)(gk + ro), (LAS unsigned*)(F.lds + PREP_RAWK + i * 1024), 16, 0, 0); } }
#pragma unroll
      for (int j = 0; j < 8; ++j) { const int t = w + 8 * j; if (t < len) __builtin_amdgcn_global_load_lds((const unsigned*)(gv + (size_t)t * QP * 2), (LAS unsigned*)(F.lds + PREP_RAWV + t * 1024), 16, 0, 0); } }
    { const int t = tid >> 3, r2 = tid & 7; unsigned wv = 0u; if (t < len) wv = *(const unsigned*)(proj + (size_t)(row0 + t) * QP + C_A1 + 2 * r2);
      a1s[t * 16 + 2 * r2] = bflo(wv); a1s[t * 16 + 2 * r2 + 1] = bfhi(wv); }
    float wa[16];
#pragma unroll
    for (int r = 0; r < 16; ++r) wa[r] = P.in[I_WA2][(size_t)l * RANK * HK + (size_t)r * HK + h * DK + d];
    const float bz = P.in[I_BA2][(size_t)l * HK + h * DK + d];
    asm volatile("s_waitcnt vmcnt(0) lgkmcnt(0)" ::: "memory"); __syncthreads();
    { const LAS bf16* rv = (const LAS bf16*)(F.lds + PREP_RAWV) + half * 256 + d;
#pragma unroll
      for (int tg = 0; tg < 8; ++tg) { unsigned vv[8];
#pragma unroll
          for (int j = 0; j < 8; ++j) { const int t = 8 * tg + j; const unsigned x = (unsigned)rv[t * 512]; vv[j] = (t < len) ? x : 0u; }
          u32x4 pv; pv.x = vv[0] | (vv[1] << 16); pv.y = vv[2] | (vv[3] << 16); pv.z = vv[4] | (vv[5] << 16); pv.w = vv[6] | (vv[7] << 16);
          PREP_ST128(VTFb + (size_t)((((half * 16 + (d >> 4)) * 2 + (tg >> 2)) * 64 + (d & 15) + 16 * (tg & 3)) * 8), pv); } }
    float bl[32];
    { float b = 0.f;
#pragma unroll
      for (int j = 0; j < 32; ++j) { const int t = 32 * half + j;
          { const LAS f32x4* ar = (const LAS f32x4*)(a1s + t * 16); const f32x4 a0 = ar[0], a1 = ar[1], a2 = ar[2], a3 = ar[3];
              float z = bz; z += a0.x * wa[0] + a0.y * wa[1] + a0.z * wa[2] + a0.w * wa[3]; z += a1.x * wa[4] + a1.y * wa[5] + a1.z * wa[6] + a1.w * wa[7];
              z += a2.x * wa[8] + a2.y * wa[9] + a2.z * wa[10] + a2.w * wa[11]; z += a3.x * wa[12] + a3.y * wa[13] + a3.z * wa[14] + a3.w * wa[15];
              const float ls = logsigmoidf_(z) * (1.0f / 16.0f); b += (t < len) ? ls : 0.f; }
          bl[j] = b; }
      if (half == 0) tot[d] = b; }
    asm volatile("s_waitcnt lgkmcnt(0)" ::: "memory"); __syncthreads();
    { const float off = half ? tot[d] : 0.f;
      const LAS bf16* rq = (const LAS bf16*)(F.lds + PREP_RAWQ) + d; const LAS bf16* rk = (const LAS bf16*)(F.lds + PREP_RAWK) + d;
#pragma unroll
      for (int g = 0; g < 4; ++g) { float kv[8];
#pragma unroll
          for (int j = 0; j < 8; ++j) { const int jj = 8 * g + j, t = 32 * half + jj; float qv = 0.f; kv[j] = 0.f;
              { const float b = bl[jj] + off; const float q0 = bf2f(rq[t * 256]) * __expf(b) * (1.0f / 16.0f), k0 = bf2f(rk[t * 256]) * __expf(-b); qv = (t < len) ? q0 : 0.f; kv[j] = (t < len) ? k0 : 0.f; }
              *(LAS bf16*)(F.lds + PREP_QS + prep_swz(t, d)) = f2bf(qv); }
          u32x4 pk; pk.x = cvt_pk_bf16(kv[0], kv[1]); pk.y = cvt_pk_bf16(kv[2], kv[3]); pk.z = cvt_pk_bf16(kv[4], kv[5]); pk.w = cvt_pk_bf16(kv[6], kv[7]);
#pragma unroll
          for (int j = 0; j < 8; ++j) { const int t = 32 * half + 8 * g + j; const unsigned wv = (j & 1) ? (pk[j >> 1] >> 16) : (pk[j >> 1] & 0xffffu); *(LAS bf16*)(F.lds + PREP_KS + prep_swz(t, d)) = (bf16)wv; }
          const int tg = 4 * half + g;
          PREP_ST128(KTFb + (size_t)((((d >> 4) * 2 + (tg >> 2)) * 64 + (d & 15) + 16 * (tg & 3)) * 8), pk); }
      if (half) __builtin_amdgcn_raw_buffer_store_b32(__builtin_bit_cast(unsigned, __expf(bl[31] + off)), rsW, (unsigned)((const unsigned char*)(EBb + d) - ws), 0, 16); }
    asm volatile("s_waitcnt lgkmcnt(0)" ::: "memory"); __syncthreads();
    const int fr = lane & 15, fq = lane >> 4;
    LAS bf16* As = (LAS bf16*)(F.lds + PREP_AS);
    { const int rt = w >> 1;
#pragma unroll
      for (int i = 0; i < 2; ++i) { const int st = 2 * (w & 1) + i; f32x4 acc = (f32x4){0.f, 0.f, 0.f, 0.f};
          if (st <= rt) {
#pragma unroll
              for (int ks = 0; ks < 8; ++ks) { const bf16x8 a = *(const LAS bf16x8*)(F.lds + PREP_QS + prep_swz(16 * rt + fr, 32 * ks + 8 * fq)); const bf16x8 bb = *(const LAS bf16x8*)(F.lds + PREP_KS + prep_swz(16 * st + fr, 32 * ks + 8 * fq));
                  acc = __builtin_amdgcn_mfma_f32_16x16x32_bf16(a, bb, acc, 0, 0, 0); } }
#pragma unroll
          for (int reg = 0; reg < 4; ++reg) { const int t = 16 * rt + 4 * fq + reg, sx = 16 * st + fr; As[t * 72 + sx] = f2bf(sx <= t ? acc[reg] : 0.f); } } }
    asm volatile("s_waitcnt lgkmcnt(0)" ::: "memory"); __syncthreads();
#pragma unroll
    for (int i = 0; i < 4; ++i) { const int f = 4 * w + i, rt = f >> 3, ks = f & 7, r = 16 * rt + fr;
        const u32x2 lo = *(const LAS u32x2*)(F.lds + PREP_QS + prep_swz(r, 32 * ks + 4 * fq)), hi = *(const LAS u32x2*)(F.lds + PREP_QS + prep_swz(r, 32 * ks + 16 + 4 * fq));
        PREP_ST128(QFb + (size_t)(f * 64 + lane) * 8, ((u32x4){lo.x, lo.y, hi.x, hi.y})); }
    { const int rt = w >> 1, ks = w & 1; const u32x4 av = *(const LAS u32x4*)(As + (16 * rt + fr) * 72 + 32 * ks + 8 * fq); PREP_ST128(AFb + (size_t)(w * 64 + lane) * 8, av); }
#undef PREP_ST128
    asm volatile("s_waitcnt lgkmcnt(0)" ::: "memory"); __syncthreads();
}

constexpr int GLA_BUFB = 66560;
static_assert(PREP_TOT + 1024 <= LDSCTL_OFF && 2 * GLA_BUFB <= LDSCTL_OFF && 8 * 9216 <= LDSCTL_OFF && RING_BYTES <= LDSCTL_OFF, "phase scratch must stay below the LDS control words");
#define GLA_ISSUE(c_, b_) do { const int u_ = ((n * NCHUNK + (c_)) * NH + h); \
        const char* q_ = (const char*)(ws + WS_QF) + (size_t)u_ * 32768 + lane * 16; const char* k_ = (const char*)(ws + WS_KTF) + (size_t)u_ * 32768 + lane * 16; \
        _Pragma("unroll") for (int i_ = 0; i_ < 4; ++i_) { \
            __builtin_amdgcn_global_load_lds((const unsigned*)(q_ + (w + 8 * i_) * 1024), (LAS unsigned*)(F.lds + (b_) * GLA_BUFB + (w + 8 * i_) * 1024), 16, 0, 0); \
            __builtin_amdgcn_global_load_lds((const unsigned*)(k_ + (w + 8 * i_) * 1024), (LAS unsigned*)(F.lds + (b_) * GLA_BUFB + 32768 + (w + 8 * i_) * 1024), 16, 0, 0); } \
        if (w == 0) __builtin_amdgcn_global_load_lds((const unsigned*)((const char*)(ws + WS_EB) + (size_t)u_ * 1024 + lane * 16), (LAS unsigned*)(F.lds + (b_) * GLA_BUFB + 65536), 16, 0, 0); } while (0)
#define GLA_LOADREG(c_, AFd, VFd) do { const int u_ = ((n * NCHUNK + (c_)) * NH + h); \
        const bf16* a_ = (const bf16*)(ws + WS_AF) + (size_t)u_ * 4096 + lane * 8; const bf16* v_ = (const bf16*)(ws + WS_VTF) + (size_t)u_ * 32768 + (size_t)dvt * 1024 + lane * 8; \
        _Pragma("unroll") for (int i_ = 0; i_ < 8; ++i_) AFd[i_] = *(const bf16x8*)(a_ + i_ * 512); \
        VFd[0] = *(const bf16x8*)(v_); VFd[1] = *(const bf16x8*)(v_ + 512); } while (0)
__device__ __forceinline__ void gla_prompt_block(const Frame& F, const Params& P, int l, int item, int lane) {
    unsigned char* ws = P.ws;
    const int w = F.wave, n = item >> 4, h = (item >> 2) & 3, dvt = (item & 3) * 8 + w;
    const int fr = lane & 15, fq = lane >> 4;
    f32x4 S[16];
#pragma unroll
    for (int i = 0; i < 16; ++i) S[i] = (f32x4){0.f, 0.f, 0.f, 0.f};
    const __amdgpu_buffer_rsrc_t rsO = __builtin_amdgcn_make_buffer_rsrc((void*)(ws + WS_OB), 0, 0x7fffffff, 0x00020000);
    unsigned* chk = (unsigned*)(ws + WS_CTL) + CW_CHK + l * CW_CHK_L + ((n * NH + h) * NCHUNK) * 64;
    bf16x8 AFc[8], VFc[2], AFn[8], VFn[2];
    const unsigned* pflag = (const unsigned*)(ws + WS_CTL) + CW_PREP + l * CW_PREP_L + (n * NH + h) * 64 + (lane < NCHUNK ? lane : NCHUNK - 1);
    unsigned* tmo = (unsigned*)(ws + WS_CTL) + CW_TMO;
    int rdy = 0;
#define GLA_WAITPREP(need_) do { if (rdy < (need_)) { unsigned spins_ = 0; \
        for (;;) { const unsigned v_ = __hip_atomic_load(pflag, __ATOMIC_RELAXED, __HIP_MEMORY_SCOPE_AGENT); const unsigned long long m_ = __ballot(v_ != 0u); rdy = (m_ == ~0ull) ? 64 : (int)__builtin_ctzll(~m_); \
            if (rdy >= (need_)) break; __builtin_amdgcn_s_sleep(8); \
            if ((++spins_ & 1023u) == 0u) { if (__hip_atomic_load(tmo, __ATOMIC_RELAXED, __HIP_MEMORY_SCOPE_AGENT) != 0u) break; if (spins_ > (1u << 17)) { __hip_atomic_store(tmo, 1u, __ATOMIC_RELAXED, __HIP_MEMORY_SCOPE_AGENT); break; } } } \
        __builtin_amdgcn_fence(__ATOMIC_ACQUIRE, "agent"); } } while (0)
    GLA_WAITPREP(1);
    GLA_ISSUE(0, 0);
    GLA_LOADREG(0, AFc, VFc);
    asm volatile("" : "+v"(AFc[0]), "+v"(AFc[1]), "+v"(AFc[2]), "+v"(AFc[3]), "+v"(AFc[4]), "+v"(AFc[5]), "+v"(AFc[6]), "+v"(AFc[7]), "+v"(VFc[0]), "+v"(VFc[1]));
#pragma unroll 1
    for (int c = 0; c < NCHUNK; ++c) {
        asm volatile("s_waitcnt vmcnt(0)" ::: "memory");
        __builtin_amdgcn_s_barrier();
        asm volatile("" ::: "memory");
        if (c > 0 && threadIdx.x == 0) __hip_atomic_fetch_add(chk + (c - 1) * 64, 1u, __ATOMIC_RELAXED, __HIP_MEMORY_SCOPE_AGENT);
        if (c + 1 < NCHUNK) { GLA_WAITPREP(c + 2); GLA_ISSUE(c + 1, (c + 1) & 1); GLA_LOADREG(c + 1, AFn, VFn); }
        const LAS unsigned char* B = F.lds + (c & 1) * GLA_BUFB + lane * 16;
        const int tok0 = (c == 0) ? 0 : NMETA + 64 * (c - 1), len = (c == 0) ? NMETA : 64, row0 = n * LP + tok0;
        f32x4 acc[4];
#pragma unroll
        for (int rt = 0; rt < 4; ++rt) acc[rt] = (f32x4){0.f, 0.f, 0.f, 0.f};
        bf16x8 qa[4], qb[4];
#pragma unroll
        for (int rt = 0; rt < 4; ++rt) qa[rt] = *(const LAS bf16x8*)(B + (rt * 8 + 0) * 1024);
#pragma unroll
        for (int ks = 0; ks < 8; ks += 2) {
#pragma unroll
            for (int rt = 0; rt < 4; ++rt) qb[rt] = *(const LAS bf16x8*)(B + (rt * 8 + ks + 1) * 1024);
            { u32x4 p; p.x = cvt_pk_bf16(S[2 * ks][0], S[2 * ks][1]); p.y = cvt_pk_bf16(S[2 * ks][2], S[2 * ks][3]); p.z = cvt_pk_bf16(S[2 * ks + 1][0], S[2 * ks + 1][1]); p.w = cvt_pk_bf16(S[2 * ks + 1][2], S[2 * ks + 1][3]);
              const bf16x8 sfk = __builtin_bit_cast(bf16x8, p);
#pragma unroll
              for (int rt = 0; rt < 4; ++rt) acc[rt] = __builtin_amdgcn_mfma_f32_16x16x32_bf16(sfk, qa[rt], acc[rt], 0, 0, 0); }
            __builtin_amdgcn_sched_group_barrier(0x100, 4, 0); __builtin_amdgcn_sched_group_barrier(0x008, 4, 0);
            if (ks + 2 < 8) {
#pragma unroll
                for (int rt = 0; rt < 4; ++rt) qa[rt] = *(const LAS bf16x8*)(B + (rt * 8 + ks + 2) * 1024); }
            { u32x4 p; p.x = cvt_pk_bf16(S[2 * ks + 2][0], S[2 * ks + 2][1]); p.y = cvt_pk_bf16(S[2 * ks + 2][2], S[2 * ks + 2][3]); p.z = cvt_pk_bf16(S[2 * ks + 3][0], S[2 * ks + 3][1]); p.w = cvt_pk_bf16(S[2 * ks + 3][2], S[2 * ks + 3][3]);
              const bf16x8 sfk = __builtin_bit_cast(bf16x8, p);
#pragma unroll
              for (int rt = 0; rt < 4; ++rt) acc[rt] = __builtin_amdgcn_mfma_f32_16x16x32_bf16(sfk, qb[rt], acc[rt], 0, 0, 0); }
            __builtin_amdgcn_sched_group_barrier(0x100, 4, 0); __builtin_amdgcn_sched_group_barrier(0x008, 4, 0);
        }
#pragma unroll
        for (int rt = 0; rt < 4; ++rt) {
            acc[rt] = __builtin_amdgcn_mfma_f32_16x16x32_bf16(VFc[0], AFc[rt * 2], acc[rt], 0, 0, 0); acc[rt] = __builtin_amdgcn_mfma_f32_16x16x32_bf16(VFc[1], AFc[rt * 2 + 1], acc[rt], 0, 0, 0);
            const int t = 16 * rt + fr; if (t < len) { u32x2 ob; ob.x = (unsigned)f2bf(acc[rt][0]) | ((unsigned)f2bf(acc[rt][1]) << 16); ob.y = (unsigned)f2bf(acc[rt][2]) | ((unsigned)f2bf(acc[rt][3]) << 16);     __builtin_amdgcn_raw_buffer_store_b64(ob, rsO, (unsigned)(((size_t)(row0 + t) * HV + h * DV + dvt * 16 + 4 * fq) * 2), 0, 16  ); }
        }
        const LAS unsigned char* EBl = F.lds + (c & 1) * GLA_BUFB + 65536 + fq * 16;
        bf16x8 ka[8], kb[8]; f32x4 ea[4], eb[4];
#define GLA_KREAD(kd, ed, g_) do { _Pragma("unroll") for (int i_ = 0; i_ < 4; ++i_) { kd[2 * i_] = *(const LAS bf16x8*)(B + 32768 + ((4 * (g_) + i_) * 2) * 1024); kd[2 * i_ + 1] = *(const LAS bf16x8*)(B + 32768 + ((4 * (g_) + i_) * 2 + 1) * 1024); \
            ed[i_] = *(const LAS f32x4*)(EBl + (4 * (g_) + i_) * 64); } } while (0)
#define GLA_KMMA(kd, ed, g_) do { _Pragma("unroll") for (int i_ = 0; i_ < 4; ++i_) { f32x4 s_ = S[4 * (g_) + i_]; s_ = __builtin_amdgcn_mfma_f32_16x16x32_bf16(kd[2 * i_], VFc[0], s_, 0, 0, 0); s_ = __builtin_amdgcn_mfma_f32_16x16x32_bf16(kd[2 * i_ + 1], VFc[1], s_, 0, 0, 0); S[4 * (g_) + i_] = s_ * ed[i_]; } } while (0)
        GLA_KREAD(ka, ea, 0);
        GLA_KREAD(kb, eb, 1); GLA_KMMA(ka, ea, 0); __builtin_amdgcn_sched_group_barrier(0x100, 12, 0); __builtin_amdgcn_sched_group_barrier(0x008, 8, 0);
        GLA_KREAD(ka, ea, 2); GLA_KMMA(kb, eb, 1); __builtin_amdgcn_sched_group_barrier(0x100, 12, 0); __builtin_amdgcn_sched_group_barrier(0x008, 8, 0);
        GLA_KREAD(kb, eb, 3); GLA_KMMA(ka, ea, 2); __builtin_amdgcn_sched_group_barrier(0x100, 12, 0); __builtin_amdgcn_sched_group_barrier(0x008, 8, 0);
        GLA_KMMA(kb, eb, 3);
#undef GLA_KREAD
#undef GLA_KMMA
        __builtin_amdgcn_sched_barrier(0);
        asm volatile("" : "+v"(AFn[0]), "+v"(AFn[1]), "+v"(AFn[2]), "+v"(AFn[3]), "+v"(AFn[4]), "+v"(AFn[5]), "+v"(AFn[6]), "+v"(AFn[7]), "+v"(VFn[0]), "+v"(VFn[1]));
#pragma unroll
        for (int i = 0; i < 8; ++i) AFc[i] = AFn[i];
        VFc[0] = VFn[0]; VFc[1] = VFn[1];
    }
    asm volatile("s_waitcnt vmcnt(0)" ::: "memory"); __builtin_amdgcn_s_barrier(); asm volatile("" ::: "memory");
    if (threadIdx.x == 0) __hip_atomic_fetch_add(chk + (NCHUNK - 1) * 64, 1u, __ATOMIC_RELAXED, __HIP_MEMORY_SCOPE_AGENT);
    float* gp = P.out + O_GP + ((size_t)((l * NB + n) * NH + h) * DK) * DV + dvt * 16 + fr;
#pragma unroll
    for (int dt = 0; dt < 16; ++dt)
#pragma unroll
        for (int reg = 0; reg < 4; ++reg) gp[(size_t)(16 * dt + 4 * fq + reg) * DV] = S[dt][reg];
}

__device__ __forceinline__ void gla_sample_block(const Frame& F, const Params& P, int l, int nh, int tid, int lane) {
    unsigned char* ws = P.ws;
    const bf16* proj = (const bf16*)(ws + WS_QKV);
    const int n = nh >> 2, h = nh & 3, row0 = NPROMPT + DECS * n, w = F.wave;
    LAS float* qs = (LAS float*)F.lds; LAS float* ks = qs + 1024; LAS float* eb = qs + 2048; LAS float* apw = qs + 2304; LAS float* obuf = (LAS float*)(F.lds + 16384);
    if (tid < 256) {
        const int col = h * DK + tid;
        float wv[16]; unsigned qr[4], kr[4]; const float bzv = P.in[I_BA2][(size_t)l * HK + col];
#pragma unroll
        for (int r = 0; r < 16; ++r) wv[r] = P.in[I_WA2][(size_t)l * RANK * HK + (size_t)r * HK + col];
#pragma unroll
        for (int t = 0; t < 4; ++t) { qr[t] = proj[(size_t)(row0 + t) * QP + C_Q + col]; kr[t] = proj[(size_t)(row0 + t) * QP + C_K + col]; }
        float z[4];
#pragma unroll
        for (int t = 0; t < 4; ++t) { z[t] = bzv;
#pragma unroll
            for (int r = 0; r < 8; ++r) { const unsigned a = *(const unsigned*)(proj + (size_t)(row0 + t) * QP + C_A1 + 2 * r); z[t] += bflo(a) * wv[2 * r] + bfhi(a) * wv[2 * r + 1]; } }
        float b = 0.f, qv[4], kv[4];
#pragma unroll
        for (int t = 0; t < 4; ++t) { b += logsigmoidf_(z[t]) * (1.0f / 16.0f); qv[t] = bf2f(qr[t]) * __expf(b) * (1.0f / 16.0f); kv[t] = bf2f(kr[t]) * __expf(-b); qs[t * 256 + tid] = qv[t]; ks[t * 256 + tid] = kv[t]; }
        eb[tid] = __expf(b);
#pragma unroll
        for (int t = 0; t < 4; ++t)
#pragma unroll
            for (int sx = 0; sx < 4; ++sx) if (sx <= t) { const float a = wave_sum(qv[t] * kv[sx]); if (lane == 0) apw[w * 16 + t * 4 + sx] = a; }
    }
    asm volatile("s_waitcnt lgkmcnt(0)" ::: "memory"); __syncthreads();
    f32x4 vv[4][2];
#pragma unroll
    for (int sx = 0; sx < 4; ++sx)
#pragma unroll
        for (int j = 0; j < 2; ++j) { const u32x2 wd = *(const u32x2*)(proj + (size_t)(row0 + sx) * QP + C_V + h * DV + 256 * j + 4 * lane); vv[sx][j] = (f32x4){bflo(wd.x), bfhi(wd.x), bflo(wd.y), bfhi(wd.y)}; }
    f32x4 oacc[4][2];
#pragma unroll
    for (int t = 0; t < 4; ++t) { oacc[t][0] = (f32x4){0.f, 0.f, 0.f, 0.f}; oacc[t][1] = (f32x4){0.f, 0.f, 0.f, 0.f}; }
    const size_t sbase = ((size_t)((l * DECB + n) * NH + h) * DK + 32 * w) * DV + 4 * lane;
    const float* Sin = P.in[I_SGLA] + sbase; float* Sout = P.out + O_GS + sbase;
#pragma unroll 1
    for (int r0 = 0; r0 < 32; r0 += 8) {
        f32x4 s4[8][2];
#pragma unroll
        for (int j = 0; j < 8; ++j) { s4[j][0] = __builtin_nontemporal_load((const f32x4*)(Sin + (size_t)(r0 + j) * DV)); s4[j][1] = __builtin_nontemporal_load((const f32x4*)(Sin + (size_t)(r0 + j) * DV + 256)); }
#pragma unroll
        for (int j = 0; j < 8; ++j) { const int d = 32 * w + r0 + j;
            const float q0 = qs[d], q1 = qs[256 + d], q2 = qs[512 + d], q3 = qs[768 + d], k0 = ks[d], k1 = ks[256 + d], k2 = ks[512 + d], k3 = ks[768 + d], e = eb[d];
#pragma unroll
            for (int c2 = 0; c2 < 2; ++c2) { const f32x4 sv = s4[j][c2];
                oacc[0][c2] += sv * q0; oacc[1][c2] += sv * q1; oacc[2][c2] += sv * q2; oacc[3][c2] += sv * q3;
                const f32x4 kvs = vv[0][c2] * k0 + vv[1][c2] * k1 + vv[2][c2] * k2 + vv[3][c2] * k3;
                __builtin_nontemporal_store((sv + kvs) * e, (f32x4*)(Sout + (size_t)(r0 + j) * DV + 256 * c2)); } }
    }
#pragma unroll
    for (int t = 0; t < 4; ++t)
#pragma unroll
        for (int c2 = 0; c2 < 2; ++c2) *(LAS f32x4*)(obuf + (w * 4 + t) * 512 + 256 * c2 + 4 * lane) = oacc[t][c2];
    asm volatile("s_waitcnt lgkmcnt(0)" ::: "memory"); __syncthreads();
    { const int t = tid >> 7, c = (tid & 127) * 4;
      f32x4 o = (f32x4){0.f, 0.f, 0.f, 0.f};
#pragma unroll
      for (int ww = 0; ww < 8; ++ww) o += *(const LAS f32x4*)(obuf + (ww * 4 + t) * 512 + c);
#pragma unroll
      for (int sx = 0; sx < 4; ++sx) if (sx <= t) { const float a = apw[0 * 16 + t * 4 + sx] + apw[1 * 16 + t * 4 + sx] + apw[2 * 16 + t * 4 + sx] + apw[3 * 16 + t * 4 + sx];
          const u32x2 wd = *(const u32x2*)(proj + (size_t)(row0 + sx) * QP + C_V + h * DV + c); o += (f32x4){bflo(wd.x), bfhi(wd.x), bflo(wd.y), bfhi(wd.y)} * a; }
      u32x2 ob; ob.x = cvt_pk_bf16(o.x, o.y); ob.y = cvt_pk_bf16(o.z, o.w);
      __builtin_amdgcn_raw_buffer_store_b64(ob, __builtin_amdgcn_make_buffer_rsrc((void*)(ws + WS_OB), 0, 0x7fffffff, 0x00020000), (unsigned)(((size_t)(row0 + t) * HV + h * DV + c) * 2), 0, 16  ); }
    asm volatile("s_waitcnt vmcnt(0) lgkmcnt(0)" ::: "memory"); __syncthreads();
    (void)__hip_atomic_fetch_add((unsigned*)(ws + WS_CTL) + CW_SMP + l * CW_SMP_L + (n * NH + h) * 16, tid == 0 ? 4u : 0u, __ATOMIC_RELAXED, __HIP_MEMORY_SCOPE_AGENT);
}

__device__ __forceinline__ void merge_unit(const Params& P, int l, int r0, int nrun, int tpos0, int seqlen, bool prompt, int seq, int h, int lane) {
    unsigned char* ws = P.ws;
    const bf16* PBb = (const bf16*)(ws + WS_PB); const bf16* GCBb = (const bf16*)(ws + WS_GCB); const bf16* GGBb = (const bf16*)(ws + WS_GGB);
    const int c = h * DV + 8 * lane;
    float p1[8], p2[8], w0[8], w1[8], w2[8], gn[8];
    { const float* cw = P.in[I_CONVW] + (size_t)l * 3 * DM + c; const f32x4 a0 = *(const f32x4*)(cw), a1 = *(const f32x4*)(cw + 4), b0 = *(const f32x4*)(cw + DM), b1 = *(const f32x4*)(cw + DM + 4), c0 = *(const f32x4*)(cw + 2 * DM), c1 = *(const f32x4*)(cw + 2 * DM + 4);
      const f32x4 g0 = *(const f32x4*)(P.in[I_GNW] + (size_t)l * DV + 8 * lane), g1 = *(const f32x4*)(P.in[I_GNW] + (size_t)l * DV + 8 * lane + 4);
#pragma unroll
      for (int j = 0; j < 4; ++j) { w0[j] = a0[j]; w0[4 + j] = a1[j]; w1[j] = b0[j]; w1[4 + j] = b1[j]; w2[j] = c0[j]; w2[4 + j] = c1[j]; gn[j] = g0[j]; gn[4 + j] = g1[j]; } }
    if (tpos0 == 0) {
        if (prompt) {
#pragma unroll
            for (int j = 0; j < 8; ++j) { p1[j] = 0.f; p2[j] = 0.f; }
        } else {
            const float* sc = P.in[I_SCONV] + ((size_t)(l * DECB + seq) * 2) * DM + c;
            const f32x4 a0 = *(const f32x4*)(sc), a1 = *(const f32x4*)(sc + 4), b0 = *(const f32x4*)(sc + DM), b1 = *(const f32x4*)(sc + DM + 4);
#pragma unroll
            for (int j = 0; j < 4; ++j) { p2[j] = a0[j]; p2[4 + j] = a1[j]; p1[j] = b0[j]; p1[4 + j] = b1[j]; }
        }
    } else {
        const u32x4 q1 = *(const u32x4*)(PBb + (size_t)(r0 - 1) * DM + c), q2 = *(const u32x4*)(PBb + (size_t)(r0 - 2) * DM + c);
#pragma unroll
        for (int j = 0; j < 4; ++j) { p1[2 * j] = bflo(q1[j]); p1[2 * j + 1] = bfhi(q1[j]); p2[2 * j] = bflo(q2[j]); p2[2 * j + 1] = bfhi(q2[j]); }
    }
    for (int t0 = 0; t0 < nrun; t0 += 4) {
        u32x4 vp[4], vgc[4], vgg[4], vo[4];
#pragma unroll
        for (int i = 0; i < 4; ++i) { const size_t row = (size_t)(r0 + t0 + i);
            vp[i] = *(const u32x4*)(PBb + row * DM + c); vgc[i] = *(const u32x4*)(GCBb + row * DM + c); vgg[i] = *(const u32x4*)(GGBb + row * DM + c);
            vo[i] = *(const u32x4*)((const bf16*)(ws + WS_OB) + row * HV + c); }
#pragma unroll
        for (int i = 0; i < 4; ++i) {
            const int t = t0 + i; const size_t row = (size_t)(r0 + t);
            float ov[8];
#pragma unroll
            for (int j = 0; j < 4; ++j) { ov[2 * j] = bflo(vo[i][j]); ov[2 * j + 1] = bfhi(vo[i][j]); }
            float ss = (ov[0] * ov[0] + ov[1] * ov[1]) + (ov[2] * ov[2] + ov[3] * ov[3]) + (ov[4] * ov[4] + ov[5] * ov[5]) + (ov[6] * ov[6] + ov[7] * ov[7]);
            ss = wave_sum(ss);
            const float rstd = 1.0f / sqrtf(ss * (1.0f / DV) + LN_EPS);
            float m[8], pn[8];
#pragma unroll
            for (int j = 0; j < 8; ++j) {
                const int q = j >> 1; const bool hi = j & 1;
                const float pc = hi ? bfhi(vp[i][q]) : bflo(vp[i][q]), gc = hi ? bfhi(vgc[i][q]) : bflo(vgc[i][q]), gg = hi ? bfhi(vgg[i][q]) : bflo(vgg[i][q]);
                pn[j] = pc;
                const float conv = w0[j] * p2[j] + w1[j] * p1[j] + w2[j] * pc;
                m[j] = gc * conv + (ov[j] * rstd * gn[j]) * gg;
                p2[j] = p1[j]; p1[j] = pc;
            }
            u32x4 mo; mo.x = cvt_pk_bf16(m[0], m[1]); mo.y = cvt_pk_bf16(m[2], m[3]); mo.z = cvt_pk_bf16(m[4], m[5]); mo.w = cvt_pk_bf16(m[6], m[7]);
            *(u32x4*)((bf16*)(ws + WS_MB) + row * DM + c) = mo;
            const int tp = tpos0 + t;
            if (tp >= seqlen - 2) {
                float* cs = prompt ? P.out + O_CP + ((size_t)(l * NB + seq) * 2 + (tp - (seqlen - 2))) * DM + c : P.out + O_CS + ((size_t)(l * DECB + seq) * 2 + (tp - (seqlen - 2))) * DM + c;
                *(f32x4*)(cs) = (f32x4){pn[0], pn[1], pn[2], pn[3]}; *(f32x4*)(cs + 4) = (f32x4){pn[4], pn[5], pn[6], pn[7]};
            }
        }
    }
}

__global__ void __launch_bounds__(512, 2) hybrid_fwd(Params P) {
    extern __shared__ __attribute__((aligned(16))) unsigned char lds_raw[];
    Frame F;
    F.lds = (LAS unsigned char*)lds_raw;
    F.wave = __builtin_amdgcn_readfirstlane((int)threadIdx.x >> 6);
    F.G = gridDim.x; { const int bx = blockIdx.x; F.vcu = (F.G % 8 == 0) ? (bx % 8) * (F.G / 8) + bx / 8 : bx; }
    unsigned char* ws = P.ws;
    for (int u = threadIdx.x; u < (LDS_BYTES - LDSCTL_OFF) / 4; u += 512) ((LAS unsigned*)(F.lds + LDSCTL_OFF))[u] = 0u;
    __syncthreads();
    XcdBarrier bar = xcd_barrier_post((unsigned*)(ws + WS_CTL) + CW_BAR, (volatile LAS unsigned*)(F.lds + MISC_OFF) + 8);
    const int gw = F.vcu * 8 + F.wave, NGW = F.G * 8;
#define GRID_BAR() xcd_barrier(bar)
#define STAMP(k) do { if (STAMP_A >= 0 && threadIdx.x == 0) __hip_atomic_fetch_max((unsigned long long*)((unsigned*)(ws + WS_CTL) + CW_STAMP) + (k), (unsigned long long)__builtin_amdgcn_s_memrealtime(), __ATOMIC_RELAXED, __HIP_MEMORY_SCOPE_AGENT); } while (0)

#if DBG_STAGE < 99
    { const size_t gt = (size_t)blockIdx.x * 512 + otid(), NGT = (size_t)F.G * 512; f32x4* o4 = (f32x4*)P.out; for (size_t i = gt; i < O_END / 4; i += NGT) o4[i] = (f32x4){0.f, 0.f, 0.f, 0.f}; }
    GRID_BAR();
#endif
    REP(0) { p0_prologue(F, P); __syncthreads(); }
    GRID_BAR();

#pragma unroll
    for (int l = 0; l < DEPTH; ++l) {
        if (DBG_STAGE < 99 && l > 0 && DBG_STAGE < 10) break;
        REP(5) { pg8::Gemm g{(const bf16*)(ws + WS_HB), (const bf16*)(ws + WS_WIN) + (size_t)l * NPROJ * DM, MP, NPROJ, DM}; pg8::StaticOrder S; S.init(MP, NPROJ, DM, F.G, (int)blockIdx.x);
          pg8::EpiInProj E{(bf16*)(ws + WS_PB), (bf16*)(ws + WS_GCB), (bf16*)(ws + WS_GGB), (bf16*)(ws + WS_QKV), QP};
          pg8::gemm_phase<pg8::EpiInProj, pg8::StaticOrder, true, true, true>(F.lds, g, S, E); }
        GRID_BAR();
        { const int lane = otid() & 63;
          { const bool chainblk = (F.vcu & 3) == 0 && (F.vcu >> 2) < NB * NH * 4;
            const int wi = F.vcu - (F.vcu >> 2) - 1, NW = F.G - NB * NH * 4;
            unsigned* pf = (unsigned*)(ws + WS_CTL) + CW_PREP + l * CW_PREP_L;
            for (int k = F.vcu; k < NPCH * NH; k = (k < F.G) ? F.G + wi : k + NW) { const int c = k >> 4, nn = (k >> 2) & 3, hh = k & 3;
                gla_prep_unit(F, P, l, nn * NCHUNK + c, hh);
                asm volatile("s_waitcnt vmcnt(0)" ::: "memory"); __syncthreads();
                if (F.wave == 0) (void)__hip_atomic_fetch_add(pf + (nn * NH + hh) * 64 + c, lane == 0 ? 1u : 0u, __ATOMIC_RELAXED, __HIP_MEMORY_SCOPE_AGENT);
                if (chainblk) break; }
            if (chainblk) { gla_prompt_block(F, P, l, F.vcu >> 2, lane); asm volatile("s_waitcnt vmcnt(0) lgkmcnt(0)" ::: "memory"); __syncthreads(); } }
          unsigned* qhead = (unsigned*)(ws + WS_CTL) + CW_QUEUE + 64 * l;
          volatile LAS int* isl = (volatile LAS int*)(F.lds + LDSCTL_OFF + 192);
          for (;;) {
              if (F.wave == 0) { const int v_ = (int)__hip_atomic_fetch_add(qhead, lane == 0 ? 1u : 0u, __ATOMIC_RELAXED, __HIP_MEMORY_SCOPE_AGENT); isl[0] = __builtin_amdgcn_readfirstlane(v_); }
              asm volatile("s_waitcnt vmcnt(0) lgkmcnt(0)" ::: "memory"); __syncthreads();
              const int it = isl[0];
              __syncthreads();
              if (it >= DECB * NH) break;
              gla_sample_block(F, P, l, it, (int)threadIdx.x, lane); }
          asm volatile("s_waitcnt vmcnt(0) lgkmcnt(0)" ::: "memory"); __syncthreads();
          constexpr int MG_CF = 30, MG_NC = 8 * MG_CF, MG_NP = MG_NC + (NCHUNK - MG_CF) * 32, MG_NT = MG_NP + 64;
          unsigned* qhead2 = (unsigned*)(ws + WS_CTL) + CW_QUEUE + 64 * (2 + l);
          volatile LAS int* gsl = (volatile LAS int*)(F.lds + LDSCTL_OFF + 64);
          unsigned* tmo = (unsigned*)(ws + WS_CTL) + CW_TMO;
          for (;;) {
              if (threadIdx.x == 0) { const int g = (int)__hip_atomic_fetch_add(qhead2, 1u, __ATOMIC_RELAXED, __HIP_MEMORY_SCOPE_AGENT);
                  if (g < MG_NT) { unsigned spins = 0; const bool prm = g < MG_NP;
                      int cc, nn; if (g < MG_NC) { cc = g >> 3; nn = (g >> 1) & 3; } else { const int f = g - MG_NC; cc = MG_CF + (f >> 5); nn = (f >> 3) & 3; }
                      for (int k = 0; k < (prm ? 4 : 8); ++k) {
                          const unsigned* cw = prm ? (const unsigned*)(ws + WS_CTL) + CW_CHK + l * CW_CHK_L + ((nn * NH + k) * NCHUNK + cc) * 64
                                                   : (const unsigned*)(ws + WS_CTL) + CW_SMP + l * CW_SMP_L + ((g - MG_NP) * 8 + k) * 16;
                          while (__hip_atomic_load(cw, __ATOMIC_RELAXED, __HIP_MEMORY_SCOPE_AGENT) < 4u) { __builtin_amdgcn_s_sleep(16);
                              if ((++spins & 1023u) == 0u) { if (__hip_atomic_load(tmo, __ATOMIC_RELAXED, __HIP_MEMORY_SCOPE_AGENT) != 0u) break; if (spins > (1u << 17)) { __hip_atomic_store(tmo, 1u, __ATOMIC_RELAXED, __HIP_MEMORY_SCOPE_AGENT); break; } } } }
                      __builtin_amdgcn_fence(__ATOMIC_ACQUIRE, "agent"); asm volatile("s_waitcnt vmcnt(0)" ::: "memory"); }
                  gsl[0] = g; }
              asm volatile("s_waitcnt lgkmcnt(0)" ::: "memory"); __syncthreads();
              const int g = gsl[0];
              __syncthreads();
              if (g >= MG_NT) break;
              { int r0, nrun, tp0, slen, sq, hh; bool pr, act = true;
                if (g < MG_NC) { const int c = g >> 3, n = (g >> 1) & 3, k = F.wave + 8 * (g & 1); pr = true; slen = LP; sq = n; nrun = 16;
                    if (c == 0) { act = k < 4; hh = k & 3; tp0 = 0; } else { hh = k & 3; tp0 = NMETA + 64 * (c - 1) + 16 * (k >> 2); }
                    r0 = n * LP + tp0; }
                else if (g < MG_NP) { const int f = g - MG_NC, c = MG_CF + (f >> 5), n = (f >> 3) & 3, v = (f & 7) * 8 + F.wave; pr = true; slen = LP; sq = n; nrun = 4;
                    hh = v & 3; tp0 = NMETA + 64 * (c - 1) + 4 * (v >> 2); r0 = n * LP + tp0; }
                else { const int v = (g - MG_NP) * 8 + F.wave; hh = v & 3; sq = v >> 2; pr = false; slen = DECS; nrun = DECS; tp0 = 0; r0 = NPROMPT + sq * DECS; }
                if (act) merge_unit(P, l, r0, nrun, tp0, slen, pr, sq, hh, lane); }
          } }
        GRID_BAR();
        if (DBG_STAGE < 3) continue;
        REP(6) { pg8::Gemm g{(const bf16*)(ws + WS_MB), (const bf16*)(ws + WS_WO) + (size_t)l * DM * DM, MP, DM, DM}; pg8::TailSplitOrder S; S.init(MP, DM, DM, F.G, (int)blockIdx.x);
          pg8::EpiResBf16 E{(bf16*)(ws + WS_TF), (const bf16*)(ws + WS_HB), DM, ALPHA, (float*)(ws + WS_PART)};
          pg8::gemm_phase<pg8::EpiResBf16, pg8::TailSplitOrder, true, true>(F.lds, g, S, E); }
        GRID_BAR();
        { const int lane = otid() & 63; const bf16* tf = (const bf16*)(ws + WS_TF);
          Row4 cur = ln_row_load(tf + (size_t)gw * DM, lane);
#pragma unroll 1
          for (int m = gw; m < NTOK; m += NGW) { const int mn = m + NGW; Row4 nxt = cur; if (mn < 8192) nxt = ln_row_load(tf + (size_t)mn * DM, lane);
              const float* part = (F.G == 256 && m >= 8192) ? (const float*)((const bf16*)(ws + WS_PART) + (size_t)((m >> 8) - 32) * 64 * 65536 + (size_t)(m & 255) * 256) : nullptr;
              ln_row_bf(tf + (size_t)m * DM, P.in[I_LN1W] + (size_t)l * DM, P.in[I_LN1B] + (size_t)l * DM, nullptr, (bf16*)(ws + WS_HB) + (size_t)m * DM, lane, part, m < 8192, cur);
              cur = nxt; } }
        GRID_BAR();
        REP(7) { pg8::Gemm g{(const bf16*)(ws + WS_HB), (const bf16*)(ws + WS_W1) + (size_t)l * DFF * DM, MP, DFF, DM}; pg8::StaticOrder S; S.init(MP, DFF, DM, F.G, (int)blockIdx.x);
          pg8::EpiBf16<1> E{(bf16*)(ws + WS_RB), DFF};
          pg8::gemm_phase<pg8::EpiBf16<1>, pg8::StaticOrder, true, true, true>(F.lds, g, S, E); }
        GRID_BAR();
        REP(8) { pg8::Gemm g{(const bf16*)(ws + WS_RB), (const bf16*)(ws + WS_W2) + (size_t)l * DM * DFF, MP, DM, DFF}; pg8::TailSplitOrder S; S.init(MP, DM, DFF, F.G, (int)blockIdx.x);
          pg8::EpiResBf16 E{(bf16*)(ws + WS_TF), (const bf16*)(ws + WS_HB), DM, ALPHA, (float*)(ws + WS_PART)};
          pg8::gemm_phase<pg8::EpiResBf16, pg8::TailSplitOrder, true, true>(F.lds, g, S, E); }
        GRID_BAR();
        { const int lane = otid() & 63;
        for (int m = gw; m < NTOK; m += NGW) {
            const bf16* src = (const bf16*)(ws + WS_TF) + (size_t)m * DM; const float* lw = P.in[I_LN2W] + (size_t)l * DM; const float* lb = P.in[I_LN2B] + (size_t)l * DM;
            const float* part = (F.G == 256 && m >= 8192) ? (const float*)((const bf16*)(ws + WS_PART) + (size_t)((m >> 8) - 32) * 64 * 65536 + (size_t)(m & 255) * 256) : nullptr;
            if (l < DEPTH - 1) ln_row_bf(src, lw, lb, nullptr, (bf16*)(ws + WS_HB) + (size_t)m * DM, lane, part);
            else { float* dst;
                if (m < NPROMPT) { const int b = m / LP, t = m % LP; if (t < NMETA) continue; dst = P.out + O_YP + ((size_t)b * SEQ + (t - NMETA)) * DM; }
                else dst = P.out + O_YS + (size_t)(m - NPROMPT) * DM;
                ln_row_bf(src, lw, lb, dst, nullptr, lane, part); }
        } }
        if (l < DEPTH - 1) GRID_BAR();
    }
#if STAMP_A >= 0
    GRID_BAR();
    { const unsigned long long* ts = (const unsigned long long*)((unsigned*)(ws + WS_CTL) + CW_STAMP);
      const unsigned long long ta = __hip_atomic_load(ts + STAMP_A, __ATOMIC_RELAXED, __HIP_MEMORY_SCOPE_AGENT), tb = __hip_atomic_load(ts + STAMP_B, __ATOMIC_RELAXED, __HIP_MEMORY_SCOPE_AGENT);
      const float Bv = floorf((float)(long long)(tb - ta) * 0.01f * (1.0f / STAMP_Q) + 0.5f) * STAMP_Q;
      for (size_t i = (size_t)blockIdx.x * 512 + threadIdx.x; i < (size_t)NSAMP * DM; i += (size_t)F.G * 512) P.out[O_YS + i] = Bv; }
#endif
}

extern "C" void kernel_launch(void* const* d_in, const int* in_sizes, int n_in, void* d_out, int out_size, void* d_ws, size_t ws_size, hipStream_t stream) {
    static int grid = 0;
    if (grid == 0) {
        if (n_in != 19 || (size_t)out_size != O_END || ws_size < WS_END) { fprintf(stderr, "kernel_launch: unexpected shapes n_in %d out %d ws %zu\n", n_in, out_size, ws_size); grid = -1; return; }
        int dev = 0, cus = 0, per_cu = 0;
        if (hipGetDevice(&dev) != hipSuccess || hipDeviceGetAttribute(&cus, hipDeviceAttributeMultiprocessorCount, dev) != hipSuccess) { grid = -1; return; }
        if (hipFuncSetAttribute((const void*)hybrid_fwd, hipFuncAttributeMaxDynamicSharedMemorySize, LDS_BYTES) != hipSuccess) { fprintf(stderr, "kernel_launch: hipFuncSetAttribute failed\n"); grid = -1; return; }
        if (hipOccupancyMaxActiveBlocksPerMultiprocessor(&per_cu, (const void*)hybrid_fwd, 512, LDS_BYTES) != hipSuccess || per_cu < 1) fprintf(stderr, "kernel_launch: occupancy query says %d\n", per_cu);
        (void)hipGetLastError();
        grid = cus;
    }
    if (grid < 0) return;
    if (hipMemsetAsync((char*)d_ws + WS_CTL, 0, CTL_ZERO_BYTES, stream) != hipSuccess) return;
    Params p{};
    for (int i = 0; i < 19; ++i) p.in[i] = (const float*)d_in[i];
    p.out = (float*)d_out; p.ws = (unsigned char*)d_ws; p.dbg = 0; p.pad = 0;
    hipLaunchKernelGGL(hybrid_fwd, dim3(grid), dim3(512), LDS_BYTES, stream, p);
}
```
